# Optimizing an MI355X kernel written in HIP

```python
import math
import jax, jax.numpy as jnp
from jax import lax
import numpy as np

D_MODEL = 1024
BATCH = 4
SEQ = 4096
DEPTH = 1

EPS = 1e-6
D_CONV = D_MODEL // 2
CONV_K = 3
HEAD_DIM = 64
N_HEADS = (D_MODEL // 2) // HEAD_DIM
N_KV_HEADS = 2
GQA_GROUP = N_HEADS // N_KV_HEADS
D_ATTN = N_HEADS * HEAD_DIM
D_KV = N_KV_HEADS * HEAD_DIM
WINDOW = 128
BLK = 128
D_MIX = D_CONV + D_ATTN
D_IN_PROJ = 3 * D_CONV + D_ATTN + 2 * D_KV
N_EXPERTS = 64
TOP_K = 8
N_GROUPS = 8
TOPK_GROUPS = 4
D_EXPERT = D_MODEL // 4
ROUTED_SCALE = 2.5
MOE_BLK = 128

kernel_name = "hymba_conv_swa_sink_alibi_moe_block"


def _alibi_slopes(n_heads):
    return np.array([2.0 ** (-8.0 * (h + 1) / n_heads) for h in range(n_heads)], dtype=np.float32)


def rms_norm(x, w):
    xf = x.astype(jnp.float32)
    y = xf * lax.rsqrt(jnp.mean(xf * xf, axis=-1, keepdims=True) + EPS)
    return (y * w.astype(jnp.float32)).astype(x.dtype)


def short_conv_mixer(b_gate, c_gate, h, conv_w):
    S = h.shape[1]
    u = c_gate * h
    u_pad = jnp.pad(u, ((0, 0), (CONV_K - 1, 0), (0, 0)))
    v = conv_w[0] * u_pad[:, 0:S]
    for k in range(1, CONV_K):
        v = v + conv_w[k] * u_pad[:, k:k + S]
    return b_gate * v


def sliding_window_attention(q, k, v, sinks):
    Bsz, S = q.shape[0], q.shape[1]
    nb = S // BLK
    qb = q.reshape(Bsz, nb, BLK, N_KV_HEADS, GQA_GROUP, HEAD_DIM)
    kb = k.reshape(Bsz, nb, BLK, N_KV_HEADS, HEAD_DIM)
    vb = v.reshape(Bsz, nb, BLK, N_KV_HEADS, HEAD_DIM)
    pad = ((0, 0), (1, 0), (0, 0), (0, 0), (0, 0))
    kk = jnp.concatenate([jnp.pad(kb, pad)[:, :-1], kb], axis=2)
    vv = jnp.concatenate([jnp.pad(vb, pad)[:, :-1], vb], axis=2)
    s = jnp.einsum('bnqhgd,bnkhd->bhgnqk', qb, kk,
                   preferred_element_type=jnp.float32) * (HEAD_DIM ** -0.5)
    qi = jnp.arange(BLK)[:, None]
    kj = jnp.arange(2 * BLK)[None, :]
    dist = qi - kj + BLK
    key_pos = jnp.arange(nb)[:, None, None] * BLK - BLK + kj[None]
    mask = (dist >= 0)[None] & (dist < WINDOW)[None] & (key_pos >= 0)
    slopes = jnp.asarray(_alibi_slopes(N_HEADS)).reshape(N_KV_HEADS, GQA_GROUP)
    bias = -slopes[:, :, None, None, None] * dist.astype(jnp.float32)[None, None, None]
    s = jnp.where(mask, s + bias, -jnp.inf)
    sink = jnp.broadcast_to(
        sinks.astype(jnp.float32).reshape(1, N_KV_HEADS, GQA_GROUP, 1, 1, 1),
        s.shape[:-1] + (1,))
    p = jax.nn.softmax(jnp.concatenate([s, sink], axis=-1), axis=-1)[..., :-1]
    o = jnp.einsum('bhgnqk,bnkhd->bnqhgd', p.astype(vv.dtype), vv)
    return o.reshape(Bsz, S, N_HEADS * HEAD_DIM)


def swiglu(x, w_gate, w_up, w_down):
    return (jax.nn.silu(x @ w_gate) * (x @ w_up)) @ w_down


def moe_ffn(xf, w_router, router_bias, w_eg, w_eu, w_ed, w_sg, w_su, w_sd):
    N, D = xf.shape
    scores = jax.nn.sigmoid(xf.astype(jnp.float32) @ w_router.astype(jnp.float32))
    biased = scores + router_bias.astype(jnp.float32)
    grp = biased.reshape(N, N_GROUPS, N_EXPERTS // N_GROUPS)
    grp_score = lax.top_k(grp, 2)[0].sum(-1)
    _, top_groups = lax.top_k(grp_score, TOPK_GROUPS)
    group_mask = jax.nn.one_hot(top_groups, N_GROUPS, dtype=jnp.float32).sum(1) > 0
    expert_mask = jnp.repeat(group_mask, N_EXPERTS // N_GROUPS, axis=1)
    _, top_idx = lax.top_k(jnp.where(expert_mask, biased, -jnp.inf), TOP_K)
    top_w = jnp.take_along_axis(scores, top_idx, axis=1)
    top_w = top_w / jnp.sum(top_w, axis=-1, keepdims=True) * ROUTED_SCALE

    A = N * TOP_K
    flat_e = top_idx.reshape(-1)
    flat_tok = jnp.repeat(jnp.arange(N, dtype=jnp.int32), TOP_K)
    flat_w = top_w.reshape(-1)
    order = jnp.argsort(flat_e)
    sorted_e = flat_e[order]
    counts = jnp.bincount(flat_e, length=N_EXPERTS)
    starts = jnp.cumsum(counts) - counts
    padded = (counts + MOE_BLK - 1) // MOE_BLK * MOE_BLK
    pad_end = jnp.cumsum(padded)
    pad_start = pad_end - padded
    dest = pad_start[sorted_e] + (jnp.arange(A) - starts[sorted_e])
    n_blocks = -(-A // MOE_BLK) + N_EXPERTS
    P = n_blocks * MOE_BLK
    buf_tok = jnp.full((P,), N, dtype=jnp.int32).at[dest].set(flat_tok[order])
    buf_w = jnp.zeros((P,), jnp.float32).at[dest].set(flat_w[order])
    block_e = jnp.clip(jnp.searchsorted(pad_end, jnp.arange(n_blocks) * MOE_BLK, side='right'),
                       0, N_EXPERTS - 1)
    x_pad = jnp.concatenate([xf, jnp.zeros((1, D), xf.dtype)], axis=0)

    def expert_block(args):
        tok, e = args
        xb = x_pad[tok]
        return swiglu(xb, w_eg[e], w_eu[e], w_ed[e])

    y = lax.map(expert_block, (buf_tok.reshape(n_blocks, MOE_BLK), block_e)).reshape(P, D)
    y = y * buf_w[:, None].astype(y.dtype)
    routed = jnp.zeros((N + 1, D), y.dtype).at[buf_tok].add(y)[:N]
    return routed + swiglu(xf, w_sg, w_su, w_sd)


def setup_inputs(seed: int = 0) -> dict:
    key = jax.random.key(seed)
    ks = jax.random.split(key, 20)
    f32 = jnp.float32
    nrm = lambda k, shape, scale: jax.random.normal(k, shape, f32) * scale
    gain = lambda k, shape: 1.0 + 0.02 * jax.random.normal(k, shape, f32)
    L = DEPTH
    return {
        "x": jax.random.normal(ks[0], (BATCH, SEQ, D_MODEL), f32),
        "mix_norm_w": gain(ks[1], (L, D_MODEL)),
        "w_in": nrm(ks[2], (L, D_MODEL, D_IN_PROJ), D_MODEL ** -0.5),
        "conv_w": nrm(ks[3], (L, CONV_K, D_CONV), CONV_K ** -0.5),
        "q_norm_w": gain(ks[4], (L, HEAD_DIM)),
        "k_norm_w": gain(ks[5], (L, HEAD_DIM)),
        "sinks": nrm(ks[6], (L, N_HEADS), 0.5),
        "conv_out_norm_w": gain(ks[7], (L, D_CONV)),
        "attn_out_norm_w": gain(ks[8], (L, D_ATTN)),
        "w_out": nrm(ks[9], (L, D_MIX, D_MODEL), D_MIX ** -0.5),
        "ffn_norm_w": gain(ks[10], (L, D_MODEL)),
        "w_router": nrm(ks[11], (L, D_MODEL, N_EXPERTS), D_MODEL ** -0.5),
        "router_bias": nrm(ks[12], (L, N_EXPERTS), 0.01),
        "w_exp_gate": nrm(ks[13], (L, N_EXPERTS, D_MODEL, D_EXPERT), D_MODEL ** -0.5),
        "w_exp_up": nrm(ks[14], (L, N_EXPERTS, D_MODEL, D_EXPERT), D_MODEL ** -0.5),
        "w_exp_down": nrm(ks[15], (L, N_EXPERTS, D_EXPERT, D_MODEL), D_EXPERT ** -0.5),
        "w_sh_gate": nrm(ks[16], (L, D_MODEL, D_EXPERT), D_MODEL ** -0.5),
        "w_sh_up": nrm(ks[17], (L, D_MODEL, D_EXPERT), D_MODEL ** -0.5),
        "w_sh_down": nrm(ks[18], (L, D_EXPERT, D_MODEL), D_EXPERT ** -0.5),
    }


def reference(x, mix_norm_w, w_in, conv_w, q_norm_w, k_norm_w, sinks, conv_out_norm_w,
              attn_out_norm_w, w_out, ffn_norm_w, w_router, router_bias, w_exp_gate,
              w_exp_up, w_exp_down, w_sh_gate, w_sh_up, w_sh_down):
    Bsz, S, D = x.shape
    for l in range(DEPTH):
        u = rms_norm(x, mix_norm_w[l])
        proj = u @ w_in[l]
        b_gate, c_gate, h, q, k, v = jnp.split(
            proj, np.cumsum([D_CONV, D_CONV, D_CONV, D_ATTN, D_KV]).tolist(), axis=-1)
        y_conv = short_conv_mixer(b_gate, c_gate, h, conv_w[l])
        q = rms_norm(q.reshape(Bsz, S, N_HEADS, HEAD_DIM), q_norm_w[l])
        k = rms_norm(k.reshape(Bsz, S, N_KV_HEADS, HEAD_DIM), k_norm_w[l])
        v = v.reshape(Bsz, S, N_KV_HEADS, HEAD_DIM)
        y_attn = sliding_window_attention(q, k, v, sinks[l])
        y_mix = jnp.concatenate([rms_norm(y_conv, conv_out_norm_w[l]),
                                 rms_norm(y_attn, attn_out_norm_w[l])], axis=-1)
        x = x + y_mix @ w_out[l]
        xn = rms_norm(x, ffn_norm_w[l]).reshape(Bsz * S, D)
        x = x + moe_ffn(xn, w_router[l], router_bias[l], w_exp_gate[l], w_exp_up[l],
                        w_exp_down[l], w_sh_gate[l], w_sh_up[l], w_sh_down[l]).reshape(Bsz, S, D)
    return x
```

```cpp
#include <hip/hip_runtime.h>
#include <cstdio>
#include <cstdint>

typedef unsigned short bf16_t;
typedef short bf16x8 __attribute__((ext_vector_type(8)));
typedef float f32x16 __attribute__((ext_vector_type(16)));
typedef float f32x4 __attribute__((ext_vector_type(4)));

constexpr int D = 1024, BATCH = 4, SEQ = 4096, M = BATCH * SEQ;
constexpr int DCONV = 512, HD = 64, NH = 8, NKV = 2, DATT = 512, DKV = 128, WIN = 128;
constexpr int NPROJ = 2304;
constexpr int OFF_B = 0, OFF_C = 512, OFF_H = 1024, OFF_Q = 1536, OFF_K = 2048, OFF_V = 2176;
constexpr int NE = 64, TOPK = 8, NG = 8, TOPG = 4, DE = 256;
constexpr float EPS = 1e-6f, RSCALE = 2.5f;
constexpr int NEX = NE + 1;
constexpr int NSLOT = M * TOPK;
constexpr int LISTCAP = M;

constexpr size_t MiB = 1u << 20;
constexpr size_t WS_CTL = 0;
constexpr size_t WS_TOK = 1 * MiB;
constexpr size_t WS_WL = 5 * MiB;
constexpr size_t WS_INV = 9 * MiB;
constexpr size_t WS_WTD = 10 * MiB;
constexpr size_t WS_P = 43 * MiB;
constexpr size_t WS_HB = 43 * MiB;
constexpr size_t WS_WTIN = 116 * MiB;
constexpr size_t WS_WTOUT = 121 * MiB;
constexpr size_t WS_WTGU = 123 * MiB;
constexpr size_t WS_U = 188 * MiB;
constexpr size_t WS_YMIX = 220 * MiB;
constexpr size_t WS_Y = 116 * MiB;
constexpr size_t WS_END = 252 * MiB;
constexpr int CW_CNT = 1024;

__device__ __forceinline__ unsigned f2bf(float f) { unsigned u = __builtin_bit_cast(unsigned, f); return (u + 0x7fffu + ((u >> 16) & 1u)) >> 16; }
__device__ __forceinline__ float bf2f(unsigned short b) { return __builtin_bit_cast(float, (unsigned)b << 16); }
__device__ __forceinline__ float wave_sum(float v) {
#pragma unroll
    for (int o = 1; o < 64; o <<= 1) v += __shfl_xor(v, o);
    return v;
}

__global__ void __launch_bounds__(256) k_transpose(const float* __restrict__ src, int K, int N, bf16_t* __restrict__ dst, int mode, size_t src_estride, size_t dst_estride) {
    __shared__ float tile[64][65];
    const float* s = src + (size_t)blockIdx.z * src_estride; bf16_t* d = dst + (size_t)blockIdx.z * dst_estride;
    const int k0 = blockIdx.y * 64, n0 = blockIdx.x * 64, tx = threadIdx.x & 63, ty = threadIdx.x >> 6;
    for (int i = ty; i < 64; i += 4) tile[i][tx] = s[(size_t)(k0 + i) * N + n0 + tx];
    __syncthreads();
    for (int i = ty; i < 64; i += 4) { const int n = n0 + i; int row = n; if (mode == 1) row = (n >> 7) * 256 + (n & 127); else if (mode == 2) row = (n >> 7) * 256 + 128 + (n & 127);
        d[(size_t)row * K + k0 + tx] = (bf16_t)f2bf(tile[tx][i]); }
}

__global__ void __launch_bounds__(256) k_rmsnorm_rows(const float* __restrict__ x, const float* __restrict__ w, bf16_t* __restrict__ out) {
    const int lane = threadIdx.x & 63, row = blockIdx.x * 4 + (threadIdx.x >> 6);
    const f32x4* xr = (const f32x4*)(x + (size_t)row * D) + lane; const f32x4* wr = (const f32x4*)w + lane;
    f32x4 v[4]; float s = 0.f;
#pragma unroll
    for (int j = 0; j < 4; ++j) { v[j] = xr[64 * j]; s += v[j].x * v[j].x + v[j].y * v[j].y + v[j].z * v[j].z + v[j].w * v[j].w; }
    const float rstd = 1.0f / sqrtf(wave_sum(s) * (1.0f / D) + EPS);
    unsigned long long* o8 = (unsigned long long*)(out + (size_t)row * D) + lane;
#pragma unroll
    for (int j = 0; j < 4; ++j) { const f32x4 ww = wr[64 * j];
        const unsigned lo = f2bf(v[j].x * rstd * ww.x) | (f2bf(v[j].y * rstd * ww.y) << 16), hi = f2bf(v[j].z * rstd * ww.z) | (f2bf(v[j].w * rstd * ww.w) << 16);
        o8[64 * j] = (unsigned long long)lo | ((unsigned long long)hi << 32); }
}

__device__ __forceinline__ f32x16 wave_gemm(const bf16_t* arow, const bf16_t* brow, int K) {
    f32x16 acc;
#pragma unroll
    for (int i = 0; i < 16; ++i) acc[i] = 0.f;
    for (int k = 0; k < K; k += 16) { const bf16x8 a = *(const bf16x8*)(arow + k); const bf16x8 b = *(const bf16x8*)(brow + k); acc = __builtin_amdgcn_mfma_f32_32x32x16_bf16(a, b, acc, 0, 0, 0); }
    return acc;
}
__device__ __forceinline__ int crow(int reg, int h) { return (reg & 3) + 8 * (reg >> 2) + 4 * h; }

__global__ void __launch_bounds__(256) k_gemm_inproj(const bf16_t* __restrict__ A, const bf16_t* __restrict__ Bt, bf16_t* __restrict__ P) {
    const int lane = threadIdx.x & 63, wv = threadIdx.x >> 6, r = lane & 31, h = lane >> 5;
    const int m0 = blockIdx.y * 32, n0 = blockIdx.x * 128 + wv * 32;
    const f32x16 acc = wave_gemm(A + (size_t)(m0 + r) * D + 8 * h, Bt + (size_t)(n0 + r) * D + 8 * h, D);
#pragma unroll
    for (int i = 0; i < 16; ++i) P[(size_t)(m0 + crow(i, h)) * NPROJ + n0 + r] = (bf16_t)f2bf(acc[i]);
}

__global__ void __launch_bounds__(256) k_gemm_outproj(const bf16_t* __restrict__ A, const bf16_t* __restrict__ Bt, const float* __restrict__ x, float* __restrict__ out) {
    const int lane = threadIdx.x & 63, wv = threadIdx.x >> 6, r = lane & 31, h = lane >> 5;
    const int m0 = blockIdx.y * 32, n0 = blockIdx.x * 128 + wv * 32;
    const f32x16 acc = wave_gemm(A + (size_t)(m0 + r) * D + 8 * h, Bt + (size_t)(n0 + r) * D + 8 * h, D);
#pragma unroll
    for (int i = 0; i < 16; ++i) { const size_t o = (size_t)(m0 + crow(i, h)) * D + n0 + r; out[o] = x[o] + acc[i]; }
}

__global__ void __launch_bounds__(256) k_conv(const bf16_t* __restrict__ P, const float* __restrict__ conv_w, const float* __restrict__ nw, bf16_t* __restrict__ ymix) {
    const int lane = threadIdx.x & 63, t = blockIdx.x * 4 + (threadIdx.x >> 6), s = t % SEQ, c0 = lane * 8;
    float v[8];
#pragma unroll
    for (int j = 0; j < 8; ++j) v[j] = 0.f;
#pragma unroll
    for (int k = 0; k < 3; ++k) { const int ds = k - 2;
        if (s + ds >= 0) { const bf16_t* row = P + (size_t)(t + ds) * NPROJ; const bf16x8 cg = *(const bf16x8*)(row + OFF_C + c0), hh = *(const bf16x8*)(row + OFF_H + c0);
#pragma unroll
            for (int j = 0; j < 8; ++j) v[j] += conv_w[k * DCONV + c0 + j] * (bf2f((unsigned short)cg[j]) * bf2f((unsigned short)hh[j])); } }
    const bf16x8 bg = *(const bf16x8*)(P + (size_t)t * NPROJ + OFF_B + c0); float ss = 0.f;
#pragma unroll
    for (int j = 0; j < 8; ++j) { v[j] *= bf2f((unsigned short)bg[j]); ss += v[j] * v[j]; }
    const float rstd = 1.0f / sqrtf(wave_sum(ss) * (1.0f / DCONV) + EPS);
    bf16x8 o;
#pragma unroll
    for (int j = 0; j < 8; ++j) o[j] = (short)f2bf(v[j] * rstd * nw[c0 + j]);
    *(bf16x8*)(ymix + (size_t)t * D + c0) = o;
}

__global__ void __launch_bounds__(256) k_attn(const bf16_t* __restrict__ P, const float* __restrict__ qnw, const float* __restrict__ knw, const float* __restrict__ sinks,
                                              const float* __restrict__ nw, bf16_t* __restrict__ ymix) {
    __shared__ float ssq[32][8];
    const int head = threadIdx.x & 7, tl = threadIdx.x >> 3, t = blockIdx.x * 32 + tl, s = t % SEQ, kvh = head >> 2;
    const float slope = exp2f(-(float)(head + 1)), sink = sinks[head];
    float q[64], o[64];
    { const bf16_t* qp = P + (size_t)t * NPROJ + OFF_Q + head * 64; float ss = 0.f;
#pragma unroll
      for (int d = 0; d < 64; ++d) { q[d] = bf2f(qp[d]); ss += q[d] * q[d]; }
      const float rs = 1.0f / sqrtf(ss * (1.0f / 64) + EPS) * 0.125f;
#pragma unroll
      for (int d = 0; d < 64; ++d) { q[d] *= rs * qnw[d]; o[d] = 0.f; } }
    float mx = sink, l = 1.0f;
    const int jlo = (s - (WIN - 1)) < 0 ? 0 : s - (WIN - 1);
    for (int js = jlo; js <= s; ++js) {
        const bf16_t* kp = P + (size_t)(t - s + js) * NPROJ + OFF_K + kvh * 64; const bf16_t* vp = kp + (OFF_V - OFF_K);
        float kk[64]; float ss = 0.f;
#pragma unroll
        for (int d = 0; d < 64; ++d) { kk[d] = bf2f(kp[d]); ss += kk[d] * kk[d]; }
        const float rs = 1.0f / sqrtf(ss * (1.0f / 64) + EPS); float dot = 0.f;
#pragma unroll
        for (int d = 0; d < 64; ++d) dot += q[d] * (kk[d] * rs * knw[d]);
        const float sc = dot - slope * (float)(s - js);
        const float mn = fmaxf(mx, sc), f = __expf(mx - mn), p = __expf(sc - mn);
        l = l * f + p; mx = mn;
#pragma unroll
        for (int d = 0; d < 64; ++d) o[d] = o[d] * f + p * bf2f(vp[d]);
    }
    const float inv = 1.0f / l; float ss = 0.f;
#pragma unroll
    for (int d = 0; d < 64; ++d) { o[d] *= inv; ss += o[d] * o[d]; }
    ssq[tl][head] = ss; __syncthreads();
    float tot = 0.f;
#pragma unroll
    for (int hh = 0; hh < 8; ++hh) tot += ssq[tl][hh];
    const float rstd = 1.0f / sqrtf(tot * (1.0f / DATT) + EPS);
    bf16_t* op = ymix + (size_t)t * D + DCONV + head * 64;
#pragma unroll
    for (int d = 0; d < 64; d += 2) *(unsigned*)(op + d) = f2bf(o[d] * rstd * nw[head * 64 + d]) | (f2bf(o[d + 1] * rstd * nw[head * 64 + d + 1]) << 16);
}

__global__ void __launch_bounds__(256) k_route(const float* __restrict__ x1, const float* __restrict__ fw, const float* __restrict__ wr, const float* __restrict__ rbias,
                                               bf16_t* __restrict__ xn, unsigned* __restrict__ cnt, int* __restrict__ tok, float* __restrict__ wl, int* __restrict__ inv) {
    __shared__ float sx[4][D]; __shared__ float ssc[4][64]; __shared__ float sg[4][8]; __shared__ int sgm[4][8];
    const int lane = threadIdx.x & 63, wv = threadIdx.x >> 6, t = blockIdx.x * 4 + wv;
    const f32x4* xr = (const f32x4*)(x1 + (size_t)t * D) + lane; const f32x4* fr = (const f32x4*)fw + lane;
    f32x4 v[4]; float s = 0.f;
#pragma unroll
    for (int j = 0; j < 4; ++j) { v[j] = xr[64 * j]; s += v[j].x * v[j].x + v[j].y * v[j].y + v[j].z * v[j].z + v[j].w * v[j].w; }
    const float rstd = 1.0f / sqrtf(wave_sum(s) * (1.0f / D) + EPS);
    unsigned long long* o8 = (unsigned long long*)(xn + (size_t)t * D) + lane;
#pragma unroll
    for (int j = 0; j < 4; ++j) { const f32x4 ww = fr[64 * j]; f32x4 y; y.x = v[j].x * rstd * ww.x; y.y = v[j].y * rstd * ww.y; y.z = v[j].z * rstd * ww.z; y.w = v[j].w * rstd * ww.w;
        *(f32x4*)&sx[wv][(lane + 64 * j) * 4] = y;
        o8[64 * j] = (unsigned long long)(f2bf(y.x) | (f2bf(y.y) << 16)) | ((unsigned long long)(f2bf(y.z) | (f2bf(y.w) << 16)) << 32); }
    __syncthreads();
    float a0 = 0.f, a1 = 0.f, a2 = 0.f, a3 = 0.f;
    for (int k = 0; k < D; k += 4) { a0 += sx[wv][k] * wr[(size_t)k * NE + lane]; a1 += sx[wv][k + 1] * wr[(size_t)(k + 1) * NE + lane]; a2 += sx[wv][k + 2] * wr[(size_t)(k + 2) * NE + lane]; a3 += sx[wv][k + 3] * wr[(size_t)(k + 3) * NE + lane]; }
    const float logit = (a0 + a1) + (a2 + a3);
    const float score = 1.0f / (1.0f + __expf(-logit)), biased = score + rbias[lane];
    ssc[wv][lane] = biased; __syncthreads();
    if (lane < 8) { float m1 = -INFINITY, m2 = -INFINITY;
        for (int j = 0; j < 8; ++j) { const float z = ssc[wv][lane * 8 + j]; if (z > m1) { m2 = m1; m1 = z; } else if (z > m2) m2 = z; }
        sg[wv][lane] = m1 + m2; }
    __syncthreads();
    if (lane < 8) { const float g = sg[wv][lane]; int c = 0;
        for (int j = 0; j < 8; ++j) { const float z = sg[wv][j]; c += (z > g) || (z == g && j < lane); }
        sgm[wv][lane] = c < TOPG; }
    __syncthreads();
    const bool gsel = sgm[wv][lane >> 3] != 0; int rank = 0;
    for (int j = 0; j < 64; ++j) { const bool js = sgm[wv][j >> 3] != 0; const float z = ssc[wv][j]; if (js) rank += (!gsel) || (z > biased) || (z == biased && j < lane); }
    const bool sel = gsel && rank < TOPK;
    const float wsum = wave_sum(sel ? score : 0.f);
    const unsigned long long bal = __ballot(sel);
    if (sel) { const int k = __popcll(bal & ((1ull << lane) - 1ull));
        const unsigned pos = atomicAdd(&cnt[lane], 1u);
        tok[(size_t)lane * LISTCAP + pos] = t; wl[(size_t)lane * LISTCAP + pos] = score / wsum * RSCALE; inv[(size_t)t * TOPK + k] = (lane << 16) | (int)pos; }
}

__global__ void __launch_bounds__(256) k_gemm1(const bf16_t* __restrict__ xn, const bf16_t* __restrict__ Wgu, const unsigned* __restrict__ cnt, const int* __restrict__ tok, bf16_t* __restrict__ hb) {
    const int e = blockIdx.z; int n_e, start;
    if (e < NE) { n_e = (int)cnt[e]; start = 0; for (int j = 0; j < e; ++j) start += (int)cnt[j]; } else { n_e = M; start = NSLOT; }
    const int m0 = blockIdx.y * 32; if (m0 >= n_e) return;
    const int lane = threadIdx.x & 63, wv = threadIdx.x >> 6, r = lane & 31, h = lane >> 5;
    const int c0 = blockIdx.x * 128 + wv * 32;
    const int ri = m0 + r; const int trow = (e < NE) ? (ri < n_e ? tok[(size_t)e * LISTCAP + ri] : 0) : ri;
    const bf16_t* W = Wgu + (size_t)e * 512 * D;
    const int cg = c0 + r, rowg = (cg >> 7) * 256 + (cg & 127), rowu = rowg + 128;
    const f32x16 g = wave_gemm(xn + (size_t)trow * D + 8 * h, W + (size_t)rowg * D + 8 * h, D);
    const f32x16 u = wave_gemm(xn + (size_t)trow * D + 8 * h, W + (size_t)rowu * D + 8 * h, D);
#pragma unroll
    for (int i = 0; i < 16; ++i) { const int rr = m0 + crow(i, h); if (rr < n_e) { const float gv = g[i]; const float sv = gv / (1.0f + __expf(-gv)) * u[i]; hb[(size_t)(start + rr) * DE + c0 + r] = (bf16_t)f2bf(sv); } }
}

__global__ void __launch_bounds__(256) k_gemm2(const bf16_t* __restrict__ hb, const bf16_t* __restrict__ Wd, const unsigned* __restrict__ cnt, const float* __restrict__ wl, bf16_t* __restrict__ y, float* __restrict__ out, int half) {
    const int e = blockIdx.z; int n_e, start;
    if (e < NE) { n_e = (int)cnt[e]; start = 0; for (int j = 0; j < e; ++j) start += (int)cnt[j]; } else { n_e = M; start = NSLOT; }
    const int m0 = blockIdx.y * 32; if (m0 >= n_e) return;
    const int lane = threadIdx.x & 63, wv = threadIdx.x >> 6, r = lane & 31, h = lane >> 5;
    const int cl = blockIdx.x * 128 + wv * 32 + r, c = half * 512 + cl;
    const f32x16 acc = wave_gemm(hb + (size_t)(start + m0 + r) * DE + 8 * h, Wd + ((size_t)e * D + c) * DE + 8 * h, DE);
#pragma unroll
    for (int i = 0; i < 16; ++i) { const int rr = m0 + crow(i, h); if (rr < n_e) {
        if (e < NE) y[(size_t)(start + rr) * 512 + cl] = (bf16_t)f2bf(acc[i] * wl[(size_t)e * LISTCAP + rr]);
        else { const size_t o = (size_t)rr * D + c; out[o] = out[o] + acc[i]; } } }
}

__global__ void __launch_bounds__(256) k_combine(const bf16_t* __restrict__ y, const unsigned* __restrict__ cnt, const int* __restrict__ inv, float* __restrict__ out, int half) {
    __shared__ int st[NE];
    if (threadIdx.x == 0) { int a = 0; for (int j = 0; j < NE; ++j) { st[j] = a; a += (int)cnt[j]; } }
    __syncthreads();
    const int lane = threadIdx.x & 63, t = blockIdx.x * 4 + (threadIdx.x >> 6);
    float a[8];
#pragma unroll
    for (int j = 0; j < 8; ++j) a[j] = 0.f;
#pragma unroll
    for (int k = 0; k < TOPK; ++k) { const int ip = inv[(size_t)t * TOPK + k]; const int row = st[ip >> 16] + (ip & 0xffff);
        const bf16x8 v = *(const bf16x8*)(y + (size_t)row * 512 + lane * 8);
#pragma unroll
        for (int j = 0; j < 8; ++j) a[j] += bf2f((unsigned short)v[j]); }
    float* o = out + (size_t)t * D + half * 512 + lane * 8;
    f32x4 o0 = *(f32x4*)o, o1 = *(f32x4*)(o + 4);
    o0.x += a[0]; o0.y += a[1]; o0.z += a[2]; o0.w += a[3]; o1.x += a[4]; o1.y += a[5]; o1.z += a[6]; o1.w += a[7];
    *(f32x4*)o = o0; *(f32x4*)(o + 4) = o1;
}

extern "C" void kernel_launch(void* const* d_in, const int* in_sizes, int n_in, void* d_out, int out_size, void* d_ws, size_t ws_size, hipStream_t stream) {
    if (n_in != 19 || in_sizes[0] != M * D || out_size != M * D || ws_size < WS_END) { fprintf(stderr, "kernel_launch: unexpected shapes/ws (n_in %d, ws %zu)\n", n_in, ws_size); return; }
    const float* x = (const float*)d_in[0]; const float* mix_w = (const float*)d_in[1]; const float* w_in = (const float*)d_in[2]; const float* conv_w = (const float*)d_in[3];
    const float* qnw = (const float*)d_in[4]; const float* knw = (const float*)d_in[5]; const float* sinks = (const float*)d_in[6]; const float* cnw = (const float*)d_in[7];
    const float* anw = (const float*)d_in[8]; const float* w_out = (const float*)d_in[9]; const float* ffw = (const float*)d_in[10]; const float* w_router = (const float*)d_in[11];
    const float* rbias = (const float*)d_in[12]; const float* w_eg = (const float*)d_in[13]; const float* w_eu = (const float*)d_in[14]; const float* w_ed = (const float*)d_in[15];
    const float* w_sg = (const float*)d_in[16]; const float* w_su = (const float*)d_in[17]; const float* w_sd = (const float*)d_in[18];
    unsigned char* ws = (unsigned char*)d_ws; float* out = (float*)d_out;
    unsigned* ctl = (unsigned*)(ws + WS_CTL); unsigned* cnt = ctl + CW_CNT;
    int* tok = (int*)(ws + WS_TOK); float* wl = (float*)(ws + WS_WL); int* inv = (int*)(ws + WS_INV);
    bf16_t* Wtd = (bf16_t*)(ws + WS_WTD); bf16_t* P = (bf16_t*)(ws + WS_P); bf16_t* hb = (bf16_t*)(ws + WS_HB); bf16_t* Wtin = (bf16_t*)(ws + WS_WTIN);
    bf16_t* Wtout = (bf16_t*)(ws + WS_WTOUT); bf16_t* Wtgu = (bf16_t*)(ws + WS_WTGU); bf16_t* U = (bf16_t*)(ws + WS_U); bf16_t* ymix = (bf16_t*)(ws + WS_YMIX); bf16_t* Y = (bf16_t*)(ws + WS_Y);
    (void)hipMemsetAsync(ws + WS_CTL, 0, 1 * MiB, stream);
    k_transpose<<<dim3(NPROJ / 64, D / 64, 1), 256, 0, stream>>>(w_in, D, NPROJ, Wtin, 0, 0, 0);
    k_transpose<<<dim3(D / 64, D / 64, 1), 256, 0, stream>>>(w_out, D, D, Wtout, 0, 0, 0);
    k_transpose<<<dim3(DE / 64, D / 64, NE), 256, 0, stream>>>(w_eg, D, DE, Wtgu, 1, (size_t)D * DE, (size_t)512 * D);
    k_transpose<<<dim3(DE / 64, D / 64, NE), 256, 0, stream>>>(w_eu, D, DE, Wtgu, 2, (size_t)D * DE, (size_t)512 * D);
    k_transpose<<<dim3(D / 64, DE / 64, NE), 256, 0, stream>>>(w_ed, DE, D, Wtd, 0, (size_t)D * DE, (size_t)D * DE);
    k_transpose<<<dim3(DE / 64, D / 64, 1), 256, 0, stream>>>(w_sg, D, DE, Wtgu + (size_t)NE * 512 * D, 1, 0, 0);
    k_transpose<<<dim3(DE / 64, D / 64, 1), 256, 0, stream>>>(w_su, D, DE, Wtgu + (size_t)NE * 512 * D, 2, 0, 0);
    k_transpose<<<dim3(D / 64, DE / 64, 1), 256, 0, stream>>>(w_sd, DE, D, Wtd + (size_t)NE * D * DE, 0, 0, 0);
    k_rmsnorm_rows<<<M / 4, 256, 0, stream>>>(x, mix_w, U);
    k_gemm_inproj<<<dim3(NPROJ / 128, M / 32), 256, 0, stream>>>(U, Wtin, P);
    k_conv<<<M / 4, 256, 0, stream>>>(P, conv_w, cnw, ymix);
    k_attn<<<M / 32, 256, 0, stream>>>(P, qnw, knw, sinks, anw, ymix);
    k_gemm_outproj<<<dim3(D / 128, M / 32), 256, 0, stream>>>(ymix, Wtout, x, out);
    k_route<<<M / 4, 256, 0, stream>>>(out, ffw, w_router, rbias, U, cnt, tok, wl, inv);
    k_gemm1<<<dim3(2, M / 32, NEX), 256, 0, stream>>>(U, Wtgu, cnt, tok, hb);
    for (int half = 0; half < 2; ++half) {
        k_gemm2<<<dim3(4, M / 32, NEX), 256, 0, stream>>>(hb, Wtd, cnt, wl, Y, out, half);
        k_combine<<<M / 4, 256, 0, stream>>>(Y, cnt, inv, out, half);
    }
}
```

```cpp
#include <hip/hip_runtime.h>
#include <cstdio>
#include <cstdint>

#define GAS __attribute__((address_space(1)))
#define LAS __attribute__((address_space(3)))
typedef unsigned short bf16_t;
typedef short bf16x8 __attribute__((ext_vector_type(8)));
typedef float f32x16 __attribute__((ext_vector_type(16)));
typedef float f32x4 __attribute__((ext_vector_type(4)));
typedef unsigned u32x4 __attribute__((ext_vector_type(4)));
typedef unsigned v4u __attribute__((ext_vector_type(4)));
typedef GAS unsigned gu32;
typedef GAS unsigned long long gu64;
#define RLX_AGENT __ATOMIC_RELAXED, __HIP_MEMORY_SCOPE_AGENT
#define LDS_WAIT() asm volatile("s_waitcnt lgkmcnt(0)" ::: "memory")
#define VM_WAIT() asm volatile("s_waitcnt vmcnt(0)" ::: "memory")

constexpr int D = 1024, BATCH = 4, SEQ = 4096, M = BATCH * SEQ;
constexpr int DCONV = 512, HD = 64, NH = 8, NKV = 2, DATT = 512, DKV = 128, WIN = 128;
constexpr int NPROJ = 2304;
constexpr int OFF_B = 0, OFF_C = 512, OFF_H = 1024, OFF_Q = 1536, OFF_K = 2048, OFF_V = 2176;
constexpr int NE = 64, TOPK = 8, NG = 8, TOPG = 4, DE = 256;
constexpr float EPS = 1e-6f, RSCALE = 2.5f;
constexpr int NEX = NE + 1;
constexpr int NSLOT = M * TOPK;
constexpr int LISTCAP = M;
constexpr int MAXTILES = 704;

constexpr size_t MiB = 1u << 20;
constexpr size_t WS_CTL = 0;
constexpr size_t WS_TOK = 1 * MiB;
constexpr size_t WS_WL = 5 * MiB;
constexpr size_t WS_INV = 9 * MiB;
constexpr size_t WS_WTD = 10 * MiB;
constexpr size_t WS_P = 43 * MiB;
constexpr size_t WS_HB = 43 * MiB;
constexpr size_t WS_WTIN = 116 * MiB;
constexpr size_t WS_WTOUT = 121 * MiB;
constexpr size_t WS_WTGU = 123 * MiB;
constexpr size_t WS_U = 188 * MiB;
constexpr size_t WS_YMIX = 220 * MiB;
constexpr size_t WS_Y = 116 * MiB;
constexpr size_t WS_END = 261 * MiB;
constexpr int CW_CNT = 1024;
constexpr int CW_BAR = 4096;

constexpr int RING_BYTES = 131072;
constexpr int MISC_OFF = RING_BYTES;
constexpr int TPRE_OFF = MISC_OFF + 128;
constexpr int RPRE_OFF = TPRE_OFF + 272;
constexpr int NCNT_OFF = RPRE_OFF + 272;
constexpr int TILEE_OFF = NCNT_OFF + 272;
constexpr int LDS_BYTES = 147456;
static_assert(TILEE_OFF + MAXTILES * 2 <= LDS_BYTES, "LDS map");

__device__ __forceinline__ unsigned f2bf(float f) { unsigned u = __builtin_bit_cast(unsigned, f); return (u + 0x7fffu + ((u >> 16) & 1u)) >> 16; }
__device__ __forceinline__ unsigned pk2(float lo, float hi) { return f2bf(lo) | (f2bf(hi) << 16); }
__device__ __forceinline__ float bf2f(unsigned short b) { return __builtin_bit_cast(float, (unsigned)b << 16); }
__device__ __forceinline__ float wave_sum(float v) {
#pragma unroll
    for (int o = 1; o < 64; o <<= 1) v += __shfl_xor(v, o);
    return v;
}
__device__ __forceinline__ int crow(int reg, int h) { return (reg & 3) + 8 * (reg >> 2) + 4 * h; }
#define XB_TMO      128
#define XB_XCNT(j)  (256  + 64 * (j))
#define XB_XSUB(j)  (1280 + 64 * (j))
#define XB_XGEN(j)  (2304 + 64 * (j))
#define XB_TOP      3328
#define XB_TOPGEN   3392
#define XCD_BAR_WORDS 3456
#define XB_SPIN_CAP (1u << 18)

__device__ __forceinline__ unsigned xb_ld(unsigned* p)              { return __hip_atomic_load(p, __ATOMIC_RELAXED, __HIP_MEMORY_SCOPE_AGENT); }
__device__ __forceinline__ unsigned xb_add(unsigned* p, unsigned v) { return __hip_atomic_fetch_add(p, v, __ATOMIC_RELAXED, __HIP_MEMORY_SCOPE_AGENT); }
__device__ __forceinline__ unsigned xb_xcc_id() { return (unsigned)__builtin_amdgcn_s_getreg((3 << 11) | 20) & 0xFu; }
#define XB_SPIN(cond, bar) do { unsigned _sp = 0; while (cond) { __builtin_amdgcn_s_sleep(1); \
    if ((++_sp & 255u) == 0u) { if (xb_ld(&(bar)[XB_TMO])) break; if (_sp > XB_SPIN_CAP) { atomicAdd(&(bar)[XB_TMO], 1u); break; } } } } while (0)

struct XcdBarrier {
    unsigned* bar; unsigned x;
    volatile LAS unsigned* st;
};

__device__ __forceinline__ XcdBarrier xcd_barrier_post(unsigned* bar, volatile LAS unsigned* st) {
    XcdBarrier b; b.bar = bar; b.x = xb_xcc_id(); b.st = st;
    if (threadIdx.x == 0) (void)xb_add(&bar[XB_XCNT(b.x)], 1u);
    return b;
}
__device__ __forceinline__ void xcd_barrier_complete(unsigned* bar, unsigned x, unsigned& nloc, unsigned& nx) {
    const unsigned G = gridDim.x * gridDim.y * gridDim.z;
    unsigned sum, cnt, mine, sp = 0u;
    for (;;) {
        sum = 0u; cnt = 0u; mine = 0u;
#pragma unroll
        for (unsigned j = 0; j < 16; ++j) { const unsigned c = xb_ld(&bar[XB_XCNT(j)]); sum += c; cnt += (c > 0u) ? 1u : 0u; mine = (j == x) ? c : mine; }
        if (sum == G) break;
        __builtin_amdgcn_s_sleep(1);
        if ((++sp & 255u) == 0u) { if (xb_ld(&bar[XB_TMO])) break; if (sp > XB_SPIN_CAP) { atomicAdd(&bar[XB_TMO], 1u); break; } }
    }
    nloc = mine > 0u ? mine : 1u; nx = cnt > 0u ? cnt : 1u;
}

__device__ __forceinline__ void xcd_barrier(const XcdBarrier& b) {
    asm volatile("s_waitcnt vmcnt(0)" ::: "memory");
    __syncthreads();
    if (threadIdx.x == 0) {
        unsigned* bar = b.bar;
        __builtin_amdgcn_s_waitcnt(0);
        unsigned nloc = b.st[0], nx = b.st[1];
        if (nloc == 0u) { xcd_barrier_complete(bar, b.x, nloc, nx); b.st[0] = nloc; b.st[1] = nx; }
        const unsigned old = xb_add(&bar[XB_XSUB(b.x)], 1u);
        const unsigned gen = old / nloc;
        if (old + 1u == (gen + 1u) * nloc) {
            __builtin_amdgcn_fence(__ATOMIC_RELEASE, "agent");
            asm volatile("s_waitcnt vmcnt(0)" ::: "memory");
            const unsigned og = xb_add(&bar[XB_TOP], 1u);
            const unsigned tg = og / nx;
            if (og + 1u == (tg + 1u) * nx) xb_add(&bar[XB_TOPGEN], 1u);
            else XB_SPIN(xb_ld(&bar[XB_TOPGEN]) == tg, bar);
            __builtin_amdgcn_fence(__ATOMIC_ACQUIRE, "agent");
            xb_add(&bar[XB_XGEN(b.x)], 1u);
            asm volatile("s_waitcnt vmcnt(0)" ::: "memory");
        } else {
            XB_SPIN(xb_ld(&bar[XB_XGEN(b.x)]) == gen, bar);
            __builtin_amdgcn_fence(__ATOMIC_ACQUIRE, "agent");
            asm volatile("s_waitcnt vmcnt(0)" ::: "memory");
        }
    }
    __syncthreads();
}
namespace pg8 {
#define PG8_LAS __attribute__((address_space(3)))
constexpr int BM = 256, BK = 64, HALF = 128, HTB = HALF * BK * 2  , STAGE_BYTES = 8 * HTB, NXCD = 8, WGM = 8;

__host__ __device__ __forceinline__ int lds_byte(int r, int c) { const int st = (r >> 4) * 2 + (c >> 5), rr = r & 15, cc = c & 31, ob = rr * 64 + cc * 2; return st * 1024 + (ob ^ (((ob >> 9) & 1) << 5)); }
__host__ __device__ __forceinline__ void stage_rc(int b, int& R, int& C) { const int st = b / 1024, sb = b % 1024, swz = sb ^ (((sb >> 9) & 1) << 5); R = (st >> 1) * 16 + swz / 64; C = (st & 1) * 32 + (swz % 64) / 2; }
__host__ __device__ __forceinline__ int perm32(int rho) { const int n = rho >> 4, i = rho & 15; return 8 * (i >> 2) + 4 * n + (i & 3); }

struct Unit { const char* aB; const char* bB; int pm, pn, e, row0, nvalid; };

__device__ __forceinline__ unsigned cvt_pk_bf16(float lo, float hi) { unsigned r; asm volatile("v_cvt_pk_bf16_f32 %0, %1, %2" : "=v"(r) : "v"(lo), "v"(hi)); return r; }

__device__ __forceinline__ int xcd_remap(int L, int nwg) { const int q = nwg / NXCD, r = nwg % NXCD, xcd = L % NXCD, off = L / NXCD; return (xcd < r ? xcd * (q + 1) : r * (q + 1) + (xcd - r) * q) + off; }

struct DenseOrder {
    const char* A; const char* Bt; int nM, nN, nwg, G, c, K;
    __device__ void init(const bf16_t* A_, const bf16_t* Bt_, int M_, int N_, int K_, int G_, int c_) { A = (const char*)A_; Bt = (const char*)Bt_; nM = M_ / BM; nN = N_ / BM; nwg = nM * nN; G = G_; c = c_; K = K_; }
    __device__ __forceinline__ bool next(int i, Unit& u) const {
        const long L = (long)i * G + c; if (L >= nwg) return false;
        const int wgid = xcd_remap((int)L, nwg);
        const int nig = WGM * nN, gid = wgid / nig, fm = gid * WGM, gsz = (nM - fm) < WGM ? (nM - fm) : WGM;
        u.pm = fm + ((wgid % nig) % gsz); u.pn = (wgid % nig) / gsz; u.e = 0; u.row0 = u.pm * BM; u.nvalid = BM;
        u.aB = A + (size_t)u.pm * BM * K * 2; u.bB = Bt + (size_t)u.pn * BM * K * 2; return true;
    }
    __device__ __forceinline__ void a_voff(const Unit&, const int (&R)[2], const int (&C)[2], unsigned (&vo)[2][2]) const {
#pragma unroll
        for (int h = 0; h < 2; ++h)
#pragma unroll
            for (int i = 0; i < 2; ++i) vo[h][i] = (unsigned)((R[i] + HALF * h) * K + C[i]) * 2u;
    }
};

template <class Epi, class Sched, bool ALIGN_EPI>
__device__ __forceinline__ void gemm_phase(PG8_LAS unsigned char* lds, const int K, const Sched& S, const Epi& E) {
    const int tid = threadIdx.x, wid = __builtin_amdgcn_readfirstlane(tid >> 6), lane = tid & 63, wr = wid >> 2, wc = wid & 3, fr = lane & 15, fq = lane >> 4;
    const int nt = K / BK;
    int RA[2], CA[2]; unsigned voffB[2];
#pragma unroll
    for (int i = 0; i < 2; ++i) { int R, C; stage_rc(tid * 16 + i * 8192, R, C); const int Rb = Epi::PERM ? ((R & ~31) + perm32(R & 31)) : R;
        RA[i] = R; CA[i] = C; voffB[i] = (unsigned)(Rb * K + C) * 2u; }
    const size_t kstep = (size_t)(BK * 2);
    const size_t hstep = (size_t)HALF * K * 2;
    const unsigned ldsw = (unsigned)wid * 1024u;
    const int aoff = lds_byte(wr * 64 + fr, fq * 8), boff = lds_byte(wc * 32 + fr, fq * 8);
#define PG8_SA(b, h) (((b) * 2 + (h)) * HTB)
#define PG8_SB(b, h) ((4 + (b) * 2 + (h)) * HTB)
#define PG8_STAGE(bufoff, gbase, voff) do { _Pragma("unroll") for (int _i = 0; _i < 2; ++_i) \
        __builtin_amdgcn_global_load_lds((const unsigned*)((const char*)(gbase) + (voff)[_i]), (PG8_LAS unsigned*)(lds + (bufoff) + ldsw + _i * 8192), 16, 0, 0); } while (0)
#define PG8_LDA(dst, b, h) do { _Pragma("unroll") for (int m = 0; m < 4; ++m) _Pragma("unroll") for (int k = 0; k < 2; ++k) dst[m][k] = *(const PG8_LAS bf16x8*)(lds + PG8_SA(b, h) + aoff + m * 2048 + k * 1024); } while (0)
#define PG8_LDB(dst, b, h) do { _Pragma("unroll") for (int n = 0; n < 2; ++n) _Pragma("unroll") for (int k = 0; k < 2; ++k) dst[n][k] = *(const PG8_LAS bf16x8*)(lds + PG8_SB(b, h) + boff + n * 2048 + k * 1024); } while (0)
#define PG8_MMA(ai, bj, At, Bt) do { __builtin_amdgcn_s_setprio(1); _Pragma("unroll") for (int m = 0; m < 4; ++m) _Pragma("unroll") for (int n = 0; n < 2; ++n) _Pragma("unroll") for (int k = 0; k < 2; ++k) \
        acc[ai][bj][m][n] = __builtin_amdgcn_mfma_f32_16x16x32_bf16(Bt[n][k], At[m][k], acc[ai][bj][m][n], 0, 0, 0); __builtin_amdgcn_s_setprio(0); } while (0)
#define PG8_WAIT_V(n) asm volatile("s_waitcnt vmcnt(" #n ")" ::: "memory")
#define PG8_WAIT_L(n) asm volatile("s_waitcnt lgkmcnt(" #n ")" ::: "memory")
#define PG8_BAR __builtin_amdgcn_s_barrier()
#define PG8_SCHED __builtin_amdgcn_sched_barrier(0)
    Unit cur, nxt; int ui = 0;
    if (!S.next(0, cur)) return;
    unsigned vA[2][2], vN[2][2];
    S.a_voff(cur, RA, CA, vA);
    f32x4 acc[2][2][4][2];
#pragma unroll
    for (int a = 0; a < 2; ++a)
#pragma unroll
        for (int b = 0; b < 2; ++b)
#pragma unroll
            for (int m = 0; m < 4; ++m)
#pragma unroll
                for (int n = 0; n < 2; ++n) acc[a][b][m][n] = (f32x4){0.f, 0.f, 0.f, 0.f};
    bf16x8 At[4][2], B0[2][2], B1[2][2];
    const char* cA = cur.aB; const char* cB = cur.bB;
    PG8_STAGE(PG8_SB(0, 0), cB, voffB); PG8_STAGE(PG8_SB(0, 1), cB + hstep, voffB); PG8_STAGE(PG8_SA(0, 0), cA, vA[0]); PG8_STAGE(PG8_SA(0, 1), cA, vA[1]);
    if (wr == 1) PG8_BAR;
    PG8_WAIT_V(2); PG8_BAR;
    PG8_STAGE(PG8_SB(1, 0), cB + kstep, voffB); PG8_STAGE(PG8_SA(1, 0), cA + kstep, vA[0]); PG8_STAGE(PG8_SB(1, 1), cB + hstep + kstep, voffB);
    PG8_WAIT_V(6); PG8_BAR;
    for (;;) {
        const bool has_next = S.next(ui + 1, nxt);
        const char* nA = has_next ? nxt.aB : cA; const char* nB = has_next ? nxt.bB : cB;
        if (has_next) S.a_voff(nxt, RA, CA, vN);
        else {
#pragma unroll
            for (int h = 0; h < 2; ++h)
#pragma unroll
                for (int i = 0; i < 2; ++i) vN[h][i] = vA[h][i]; }
#pragma unroll 1
        for (int t = 0; t < nt; t += 2) {
            const bool last = (t == nt - 2);
            const char* a1 = cA + (size_t)(t + 1) * kstep;
            const char* a2 = last ? nA : cA + (size_t)(t + 2) * kstep; const char* b2 = last ? nB : cB + (size_t)(t + 2) * kstep;
            const char* a3 = a2 + kstep; const char* b3 = b2 + kstep;
            unsigned w2[2][2];
#pragma unroll
            for (int h = 0; h < 2; ++h)
#pragma unroll
                for (int i = 0; i < 2; ++i) w2[h][i] = last ? vN[h][i] : vA[h][i];
            PG8_LDB(B0, 0, 0); PG8_LDB(B1, 0, 1); PG8_SCHED; PG8_LDA(At, 0, 0); PG8_STAGE(PG8_SA(1, 1), a1, vA[1]);
            PG8_WAIT_V(8); PG8_WAIT_L(0); PG8_BAR; PG8_MMA(0, 0, At, B0); PG8_MMA(0, 1, At, B1); PG8_BAR; PG8_SCHED;
            PG8_LDA(At, 0, 1); PG8_STAGE(PG8_SB(0, 0), b2, voffB); PG8_STAGE(PG8_SB(0, 1), b2 + hstep, voffB); PG8_STAGE(PG8_SA(0, 0), a2, w2[0]);
            PG8_WAIT_V(8); PG8_WAIT_L(0); PG8_BAR; PG8_MMA(1, 0, At, B0); PG8_MMA(1, 1, At, B1); PG8_BAR; PG8_SCHED;
            PG8_LDB(B0, 1, 0); PG8_LDB(B1, 1, 1); PG8_SCHED; PG8_LDA(At, 1, 0); PG8_STAGE(PG8_SA(0, 1), a2, w2[1]);
            PG8_WAIT_V(8); PG8_WAIT_L(0); PG8_BAR; PG8_MMA(0, 0, At, B0); PG8_MMA(0, 1, At, B1); PG8_BAR; PG8_SCHED;
            PG8_LDA(At, 1, 1); PG8_STAGE(PG8_SB(1, 0), b3, voffB); PG8_STAGE(PG8_SB(1, 1), b3 + hstep, voffB); PG8_STAGE(PG8_SA(1, 0), a3, w2[0]);
            PG8_WAIT_V(8); PG8_WAIT_L(0); PG8_BAR; PG8_MMA(1, 0, At, B0); PG8_MMA(1, 1, At, B1); PG8_BAR; PG8_SCHED;
        }
        if constexpr (ALIGN_EPI) { if (wr == 0) PG8_BAR; }
        E(acc, cur, wr, wc, fr, fq);
        if (!has_next) break;
#pragma unroll
        for (int a = 0; a < 2; ++a)
#pragma unroll
            for (int b = 0; b < 2; ++b)
#pragma unroll
                for (int m = 0; m < 4; ++m)
#pragma unroll
                    for (int n = 0; n < 2; ++n) acc[a][b][m][n] = (f32x4){0.f, 0.f, 0.f, 0.f};
        cur = nxt; cA = nA; cB = nB; ++ui;
#pragma unroll
        for (int h = 0; h < 2; ++h)
#pragma unroll
            for (int i = 0; i < 2; ++i) vA[h][i] = vN[h][i];
        if constexpr (ALIGN_EPI) { if (wr == 1) PG8_BAR; }
    }
    PG8_WAIT_V(0);
    if constexpr (!ALIGN_EPI) { if (wr == 0) PG8_BAR; }
    PG8_BAR;
#undef PG8_SA
#undef PG8_SB
#undef PG8_STAGE
#undef PG8_LDA
#undef PG8_LDB
#undef PG8_MMA
#undef PG8_WAIT_V
#undef PG8_WAIT_L
#undef PG8_BAR
#undef PG8_SCHED
}

struct EpiBf16 {
    static constexpr bool PERM = true;
    bf16_t* O; int ldc;
    __device__ __forceinline__ void operator()(const f32x4 (&acc)[2][2][4][2], const Unit& u, int wr, int wc, int fr, int fq) const {
        const int row0 = u.row0 + wr * 64 + fr, col0 = u.pn * BM + wc * 32 + 8 * fq;
#pragma unroll
        for (int ai = 0; ai < 2; ++ai)
#pragma unroll
            for (int m = 0; m < 4; ++m) { bf16_t* rowp = O + (size_t)(row0 + ai * HALF + m * 16) * ldc + col0;
#pragma unroll
                for (int bj = 0; bj < 2; ++bj) { const f32x4 v0 = acc[ai][bj][m][0], v1 = acc[ai][bj][m][1];
                    u32x4 w; w.x = cvt_pk_bf16(v0[0], v0[1]); w.y = cvt_pk_bf16(v0[2], v0[3]); w.z = cvt_pk_bf16(v1[0], v1[1]); w.w = cvt_pk_bf16(v1[2], v1[3]);
                    *(u32x4*)(rowp + bj * HALF) = w; } }
    }
};
struct EpiResF32 {
    static constexpr bool PERM = false;
    const float* base; float* out; int ldc;
    __device__ __forceinline__ void operator()(const f32x4 (&acc)[2][2][4][2], const Unit& u, int wr, int wc, int fr, int fq) const {
        const int row0 = u.row0 + wr * 64 + fr, col0 = u.pn * BM + wc * 32 + 4 * fq;
#pragma unroll
        for (int ai = 0; ai < 2; ++ai)
#pragma unroll
            for (int m = 0; m < 4; ++m) { const size_t off = (size_t)(row0 + ai * HALF + m * 16) * ldc + col0;
#pragma unroll
                for (int bj = 0; bj < 2; ++bj)
#pragma unroll
                    for (int n = 0; n < 2; ++n) { const f32x4 b = *(const f32x4*)(base + off + bj * HALF + n * 16); *(f32x4*)(out + off + bj * HALF + n * 16) = b + acc[ai][bj][m][n]; } }
    }
};
__device__ __forceinline__ float silu_mul(float g, float u) { return g * __builtin_amdgcn_rcpf(1.0f + __expf(-g)) * u; }
struct EpiSwiglu {
    static constexpr bool PERM = true;
    bf16_t* H;
    __device__ __forceinline__ void operator()(const f32x4 (&acc)[2][2][4][2], const Unit& u, int wr, int wc, int fr, int fq) const {
        const int rt0 = wr * 64 + fr, col0 = u.pn * HALF + wc * 32 + 8 * fq;
#pragma unroll
        for (int ai = 0; ai < 2; ++ai)
#pragma unroll
            for (int m = 0; m < 4; ++m) { const int rt = rt0 + ai * HALF + m * 16;
                if (rt < u.nvalid) { const f32x4 g0 = acc[ai][0][m][0], g1 = acc[ai][0][m][1], u0 = acc[ai][1][m][0], u1 = acc[ai][1][m][1];
                    u32x4 w; w.x = cvt_pk_bf16(silu_mul(g0[0], u0[0]), silu_mul(g0[1], u0[1])); w.y = cvt_pk_bf16(silu_mul(g0[2], u0[2]), silu_mul(g0[3], u0[3]));
                    w.z = cvt_pk_bf16(silu_mul(g1[0], u1[0]), silu_mul(g1[1], u1[1])); w.w = cvt_pk_bf16(silu_mul(g1[2], u1[2]), silu_mul(g1[3], u1[3]));
                    *(u32x4*)(H + (size_t)(u.row0 + rt) * DE + col0) = w; } }
    }
};
struct EpiDown {
    static constexpr bool PERM = true;
    bf16_t* Y; const float* wl; int half;
    __device__ __forceinline__ void operator()(const f32x4 (&acc)[2][2][4][2], const Unit& u, int wr, int wc, int fr, int fq) const {
        const int rt0 = wr * 64 + fr, cl0 = (u.pn - 2 * half) * BM + wc * 32 + 8 * fq;
        const float* wrow = wl + (size_t)(u.e < NE ? u.e : 0) * LISTCAP + u.pm * BM;
#pragma unroll
        for (int ai = 0; ai < 2; ++ai)
#pragma unroll
            for (int m = 0; m < 4; ++m) { const int rt = rt0 + ai * HALF + m * 16;
                if (rt < u.nvalid) { const float w = (u.e < NE) ? wrow[rt] : 1.0f; bf16_t* rowp = Y + (size_t)(u.row0 + rt) * 512 + cl0;
#pragma unroll
                    for (int bj = 0; bj < 2; ++bj) { const f32x4 v0 = acc[ai][bj][m][0] * w, v1 = acc[ai][bj][m][1] * w;
                        u32x4 p; p.x = cvt_pk_bf16(v0[0], v0[1]); p.y = cvt_pk_bf16(v0[2], v0[3]); p.z = cvt_pk_bf16(v1[0], v1[1]); p.w = cvt_pk_bf16(v1[2], v1[3]);
                        *(u32x4*)(rowp + bj * HALF) = p; } } }
    }
};

template <bool GATHER> struct GroupedOrder {
    const PG8_LAS int* tpre; const PG8_LAS int* rpre; const PG8_LAS int* ncnt; const PG8_LAS unsigned short* tile_e;
    const char* A; const char* Bt; const int* tok; size_t b_estride; int npn, pn0, nU, G, c, K;
    __device__ __forceinline__ bool next(int i, Unit& u) const {
        const long L = (long)i * G + c; if (L >= nU) return false;
        const int wgid = xcd_remap((int)L, nU), tile = wgid / npn, pnl = wgid % npn;
        const int e = __builtin_amdgcn_readfirstlane((int)tile_e[tile]);
        const int mt = tile - __builtin_amdgcn_readfirstlane(tpre[e]), r0 = __builtin_amdgcn_readfirstlane(rpre[e]) + mt * BM, ne = __builtin_amdgcn_readfirstlane(ncnt[e]);
        u.e = e; u.pm = mt; u.pn = pn0 + pnl; u.row0 = r0; u.nvalid = (ne - mt * BM) < BM ? (ne - mt * BM) : BM;
        u.aB = GATHER ? A : A + (size_t)r0 * K * 2; u.bB = Bt + (size_t)e * b_estride + (size_t)u.pn * BM * K * 2; return true;
    }
    __device__ __forceinline__ void a_voff(const Unit& u, const int (&R)[2], const int (&C)[2], unsigned (&vo)[2][2]) const {
#pragma unroll
        for (int h = 0; h < 2; ++h)
#pragma unroll
            for (int i = 0; i < 2; ++i) { const int rt = R[i] + HALF * h;
                if (GATHER) { int t = 0; if (rt < u.nvalid) t = (u.e < NE) ? tok[(size_t)u.e * LISTCAP + u.pm * BM + rt] : (u.pm * BM + rt);
                    vo[h][i] = (unsigned)(t * K + C[i]) * 2u; }
                else vo[h][i] = (unsigned)(rt * K + C[i]) * 2u; }
    }
};
}

constexpr int NWAVES = 8;
struct Args { const float* in[19]; float* out; unsigned char* ws; int ph_lo, ph_hi; };

__device__ __forceinline__ void p0_transpose_item(const float* W, int K, int N, bf16_t* WT, int mode, LAS float* scr, int item, int lane) {
    const int nblk = N / 32, kb = item / nblk, nb = item % nblk, k0 = 64 * kb, n0 = 32 * nb;
    const int rowbase = (mode == 0) ? n0 : ((n0 >> 7) * 256 + (n0 & 127) + (mode == 2 ? 128 : 0));
#pragma unroll 8
    for (int i = 0; i < 32; ++i) { const int kk = 2 * i + (lane >> 5); scr[kk * 33 + (lane & 31)] = W[(size_t)(k0 + kk) * N + n0 + (lane & 31)]; }
    LDS_WAIT(); asm volatile("" ::: "memory");
    const int c = lane & 7;
#pragma unroll
    for (int j = 0; j < 4; ++j) { const int n = (lane >> 3) + 8 * j; const LAS float* s = scr + (8 * c) * 33 + n;
        v4u o; o.x = pk2(s[0 * 33], s[1 * 33]); o.y = pk2(s[2 * 33], s[3 * 33]); o.z = pk2(s[4 * 33], s[5 * 33]); o.w = pk2(s[6 * 33], s[7 * 33]);
        *(GAS v4u*)(WT + (size_t)(rowbase + n) * K + k0 + 8 * c) = o; }
    LDS_WAIT(); asm volatile("" ::: "memory");
}
__device__ __forceinline__ void rms_row_to_bf16(const float* xrow, const float* w, bf16_t* orow, int lane) {
    const f32x4* xr = (const f32x4*)xrow + lane; const f32x4* wr = (const f32x4*)w + lane;
    f32x4 v[4]; float s = 0.f;
#pragma unroll
    for (int j = 0; j < 4; ++j) { v[j] = xr[64 * j]; s += (v[j].x * v[j].x + v[j].y * v[j].y) + (v[j].z * v[j].z + v[j].w * v[j].w); }
    const float rstd = 1.0f / sqrtf(wave_sum(s) * (1.0f / D) + EPS);
    unsigned long long* o8 = (unsigned long long*)orow + lane;
#pragma unroll
    for (int j = 0; j < 4; ++j) { const f32x4 ww = wr[64 * j];
        o8[64 * j] = (unsigned long long)pk2(v[j].x * rstd * ww.x, v[j].y * rstd * ww.y) | ((unsigned long long)pk2(v[j].z * rstd * ww.z, v[j].w * rstd * ww.w) << 32); }
}

__device__ __forceinline__ void conv_token(const bf16_t* P, const float* conv_w, const float* nw, bf16_t* ymix, int t, int lane) {
    const int s = t % SEQ, c0 = lane * 8;
    float v[8];
#pragma unroll
    for (int j = 0; j < 8; ++j) v[j] = 0.f;
#pragma unroll
    for (int k = 0; k < 3; ++k) { const int ds = k - 2;
        if (s + ds >= 0) { const bf16_t* row = P + (size_t)(t + ds) * NPROJ; const bf16x8 cg = *(const bf16x8*)(row + OFF_C + c0), hh = *(const bf16x8*)(row + OFF_H + c0);
#pragma unroll
            for (int j = 0; j < 8; ++j) v[j] += conv_w[k * DCONV + c0 + j] * (bf2f((unsigned short)cg[j]) * bf2f((unsigned short)hh[j])); } }
    const bf16x8 bg = *(const bf16x8*)(P + (size_t)t * NPROJ + OFF_B + c0); float ss = 0.f;
#pragma unroll
    for (int j = 0; j < 8; ++j) { v[j] *= bf2f((unsigned short)bg[j]); ss += v[j] * v[j]; }
    const float rstd = 1.0f / sqrtf(wave_sum(ss) * (1.0f / DCONV) + EPS);
    bf16x8 o;
#pragma unroll
    for (int j = 0; j < 8; ++j) o[j] = (short)f2bf(v[j] * rstd * nw[c0 + j]);
    *(bf16x8*)(ymix + (size_t)t * D + c0) = o;
}
__device__ __forceinline__ void attn_naive_block(const bf16_t* P, const float* qnw, const float* knw, const float* sinks, const float* nw, bf16_t* ymix, int t0, float* ssq  ) {
    const int hf = threadIdx.x & 1, head = (threadIdx.x >> 1) & 7, tl = threadIdx.x >> 4, t = t0 + tl, s = t % SEQ, kvh = head >> 2, d0 = hf * 32;
    const float slope = exp2f(-(float)(head + 1)), sink = sinks[head];
    float q[32], o[32];
    { const bf16_t* qp = P + (size_t)t * NPROJ + OFF_Q + head * 64 + d0; float ss = 0.f;
#pragma unroll
      for (int d = 0; d < 32; ++d) { q[d] = bf2f(qp[d]); ss += q[d] * q[d]; }
      ss += __shfl_xor(ss, 1);
      const float rs = 1.0f / sqrtf(ss * (1.0f / 64) + EPS) * 0.125f;
#pragma unroll
      for (int d = 0; d < 32; ++d) { q[d] *= rs * qnw[d0 + d]; o[d] = 0.f; } }
    float mx = sink, l = 1.0f;
    const int jlo = (s - (WIN - 1)) < 0 ? 0 : s - (WIN - 1);
    for (int js = jlo; js <= s; ++js) {
        const bf16_t* kp = P + (size_t)(t - s + js) * NPROJ + OFF_K + kvh * 64 + d0; const bf16_t* vp = kp + (OFF_V - OFF_K);
        float ss = 0.f, dot = 0.f;
#pragma unroll
        for (int d = 0; d < 32; ++d) { const float kk = bf2f(kp[d]); ss += kk * kk; dot += q[d] * (kk * knw[d0 + d]); }
        ss += __shfl_xor(ss, 1); dot += __shfl_xor(dot, 1);
        const float rs = 1.0f / sqrtf(ss * (1.0f / 64) + EPS);
        const float sc = dot * rs - slope * (float)(s - js);
        const float mn = fmaxf(mx, sc), f = __expf(mx - mn), p = __expf(sc - mn);
        l = l * f + p; mx = mn;
#pragma unroll
        for (int d = 0; d < 32; ++d) o[d] = o[d] * f + p * bf2f(vp[d]);
    }
    const float inv = 1.0f / l; float ss = 0.f;
#pragma unroll
    for (int d = 0; d < 32; ++d) { o[d] *= inv; ss += o[d] * o[d]; }
    ss += __shfl_xor(ss, 1);
    if (hf == 0) ssq[tl * 8 + head] = ss;
    __syncthreads();
    float tot = 0.f;
#pragma unroll
    for (int hh = 0; hh < 8; ++hh) tot += ssq[tl * 8 + hh];
    const float rstd = 1.0f / sqrtf(tot * (1.0f / DATT) + EPS);
    bf16_t* op = ymix + (size_t)t * D + DCONV + head * 64 + d0;
#pragma unroll
    for (int d = 0; d < 32; d += 2) *(unsigned*)(op + d) = f2bf(o[d] * rstd * nw[head * 64 + d0 + d]) | (f2bf(o[d + 1] * rstd * nw[head * 64 + d0 + d + 1]) << 16);
    __syncthreads();
}

__device__ __forceinline__ void route_token(const float* x1, const float* fw, const float* wr, const float* rbias, bf16_t* xn, unsigned* cnt, int* tok, float* wl, int* inv,
                                            int t, int lane, float* sx  , float* ssc  , float* sg  , int* sgm  ) {
    const f32x4* xr = (const f32x4*)(x1 + (size_t)t * D) + lane; const f32x4* fr = (const f32x4*)fw + lane;
    f32x4 v[4]; float s = 0.f;
#pragma unroll
    for (int j = 0; j < 4; ++j) { v[j] = xr[64 * j]; s += (v[j].x * v[j].x + v[j].y * v[j].y) + (v[j].z * v[j].z + v[j].w * v[j].w); }
    const float rstd = 1.0f / sqrtf(wave_sum(s) * (1.0f / D) + EPS);
    unsigned long long* o8 = (unsigned long long*)(xn + (size_t)t * D) + lane;
#pragma unroll
    for (int j = 0; j < 4; ++j) { const f32x4 ww = fr[64 * j]; f32x4 y; y.x = v[j].x * rstd * ww.x; y.y = v[j].y * rstd * ww.y; y.z = v[j].z * rstd * ww.z; y.w = v[j].w * rstd * ww.w;
        *(f32x4*)&sx[(lane + 64 * j) * 4] = y;
        o8[64 * j] = (unsigned long long)pk2(y.x, y.y) | ((unsigned long long)pk2(y.z, y.w) << 32); }
    LDS_WAIT(); asm volatile("" ::: "memory");
    float a0 = 0.f, a1 = 0.f, a2 = 0.f, a3 = 0.f;
    for (int k = 0; k < D; k += 4) { a0 += sx[k] * wr[(size_t)k * NE + lane]; a1 += sx[k + 1] * wr[(size_t)(k + 1) * NE + lane]; a2 += sx[k + 2] * wr[(size_t)(k + 2) * NE + lane]; a3 += sx[k + 3] * wr[(size_t)(k + 3) * NE + lane]; }
    const float logit = (a0 + a1) + (a2 + a3);
    const float score = 1.0f / (1.0f + __expf(-logit)), biased = score + rbias[lane];
    ssc[lane] = biased; LDS_WAIT(); asm volatile("" ::: "memory");
    if (lane < 8) { float m1 = -INFINITY, m2 = -INFINITY;
        for (int j = 0; j < 8; ++j) { const float z = ssc[lane * 8 + j]; if (z > m1) { m2 = m1; m1 = z; } else if (z > m2) m2 = z; }
        sg[lane] = m1 + m2; }
    LDS_WAIT(); asm volatile("" ::: "memory");
    if (lane < 8) { const float g = sg[lane]; int c = 0;
        for (int j = 0; j < 8; ++j) { const float z = sg[j]; c += (z > g) || (z == g && j < lane); }
        sgm[lane] = c < TOPG; }
    LDS_WAIT(); asm volatile("" ::: "memory");
    const bool gsel = sgm[lane >> 3] != 0; int rank = 0;
    for (int j = 0; j < 64; ++j) { const bool js = sgm[j >> 3] != 0; const float z = ssc[j]; if (js) rank += (!gsel) || (z > biased) || (z == biased && j < lane); }
    const bool sel = gsel && rank < TOPK;
    const float wsum = wave_sum(sel ? score : 0.f);
    const unsigned long long bal = __ballot(sel);
    if (sel) { const int k = __popcll(bal & ((1ull << lane) - 1ull));
        const unsigned pos = atomicAdd(&cnt[lane], 1u);
        tok[(size_t)lane * LISTCAP + pos] = t; wl[(size_t)lane * LISTCAP + pos] = score / wsum * RSCALE; inv[(size_t)t * TOPK + k] = (lane << 16) | (int)pos; }
    LDS_WAIT(); asm volatile("" ::: "memory");
}

__device__ __forceinline__ void build_group_tables(LAS unsigned char* lds, const unsigned* cnt, int& ntiles) {
    LAS int* tpre = (LAS int*)(lds + TPRE_OFF); LAS int* rpre = (LAS int*)(lds + RPRE_OFF); LAS int* ncnt = (LAS int*)(lds + NCNT_OFF); LAS unsigned short* tile_e = (LAS unsigned short*)(lds + TILEE_OFF);
    if (threadIdx.x == 0) { int tp = 0, rp = 0;
        for (int e = 0; e < NEX; ++e) { const int n = (e < NE) ? (int)cnt[e] : M; tpre[e] = tp; rpre[e] = rp; ncnt[e] = n; tp += (n + 255) >> 8; rp += n; }
        tpre[NEX] = tp; rpre[NEX] = rp; ncnt[NEX] = 0; }
    __syncthreads();
    ntiles = tpre[NEX];
    for (int e = threadIdx.x >> 3; e < NEX; e += 64) { const int a = tpre[e], b = tpre[e + 1]; for (int t = a + (threadIdx.x & 7); t < b; t += 8) tile_e[t] = (unsigned short)e; }
    __syncthreads();
}

__device__ __forceinline__ void combine_token(const bf16_t* y, const LAS int* rpre, const int* inv, float* out, int half, int t, int lane) {
    float a[8];
#pragma unroll
    for (int j = 0; j < 8; ++j) a[j] = 0.f;
#pragma unroll
    for (int k = 0; k < TOPK; ++k) { const int ip = inv[(size_t)t * TOPK + k]; const int row = rpre[ip >> 16] + (ip & 0xffff);
        const bf16x8 v = *(const bf16x8*)(y + (size_t)row * 512 + lane * 8);
#pragma unroll
        for (int j = 0; j < 8; ++j) a[j] += bf2f((unsigned short)v[j]); }
    { const bf16x8 v = *(const bf16x8*)(y + (size_t)(NSLOT + t) * 512 + lane * 8);
#pragma unroll
      for (int j = 0; j < 8; ++j) a[j] += bf2f((unsigned short)v[j]); }
    float* o = out + (size_t)t * D + half * 512 + lane * 8;
    f32x4 o0 = *(f32x4*)o, o1 = *(f32x4*)(o + 4);
    o0.x += a[0]; o0.y += a[1]; o0.z += a[2]; o0.w += a[3]; o1.x += a[4]; o1.y += a[5]; o1.z += a[6]; o1.w += a[7];
    *(f32x4*)o = o0; *(f32x4*)(o + 4) = o1;
}

constexpr int N_PHASES = 11;
__global__ void __launch_bounds__(NWAVES * 64, 2) mega_fwd(Args args) {
    extern __shared__ __attribute__((aligned(16))) unsigned char lds_raw[];
    LAS unsigned char* lds = (LAS unsigned char*)lds_raw;
    volatile LAS unsigned* MISC = (volatile LAS unsigned*)(lds + MISC_OFF);
    const int tid = threadIdx.x, lane = tid & 63, wave = __builtin_amdgcn_readfirstlane(tid >> 6);
    const int G = gridDim.x; const int bx = blockIdx.x; const int vcu = (G % 8 == 0) ? (bx % 8) * (G / 8) + bx / 8 : bx;
    unsigned char* ws = args.ws;
    gu32* ctl = (gu32*)(ws + WS_CTL);
    float* out = args.out;
    unsigned* cnt = (unsigned*)(ws + WS_CTL) + CW_CNT;
    int* tok = (int*)(ws + WS_TOK); float* wl = (float*)(ws + WS_WL); int* inv = (int*)(ws + WS_INV);
    bf16_t* Wtd = (bf16_t*)(ws + WS_WTD); bf16_t* P = (bf16_t*)(ws + WS_P); bf16_t* hb = (bf16_t*)(ws + WS_HB); bf16_t* Wtin = (bf16_t*)(ws + WS_WTIN);
    bf16_t* Wtout = (bf16_t*)(ws + WS_WTOUT); bf16_t* Wtgu = (bf16_t*)(ws + WS_WTGU); bf16_t* U = (bf16_t*)(ws + WS_U); bf16_t* ymix = (bf16_t*)(ws + WS_YMIX); bf16_t* Y = (bf16_t*)(ws + WS_Y);

    for (int u = tid; u < 32; u += NWAVES * 64) ((LAS unsigned*)(lds + MISC_OFF))[u] = 0u;
    __syncthreads();
    const int lo = args.ph_lo, hi = args.ph_hi;
    const bool use_bar = (hi - lo) > 1;
    XcdBarrier bar; bar.bar = (unsigned*)(ctl + CW_BAR); bar.x = 0; bar.st = nullptr;
    if (use_bar) bar = xcd_barrier_post((unsigned*)(ctl + CW_BAR), MISC + 8);
#define IN(k) (lo <= (k) && (k) < hi)
#define SEAM(k) do { if (IN(k) && IN((k) + 1)) xcd_barrier(bar); } while (0)
    const int gw = vcu * NWAVES + wave, NGW = G * NWAVES;

    if (IN(0)) {
        LAS float* scr = (LAS float*)(lds + wave * 16384);
        constexpr int I_IN = (D / 64) * (NPROJ / 32), I_OUT = (D / 64) * (D / 32), I_G = (D / 64) * (DE / 32), I_D = (DE / 64) * (D / 32);
        constexpr int NITEMS = I_IN + I_OUT + NEX * (2 * I_G + I_D);
        for (int it = gw; it < NITEMS; it += NGW) {
            int r = it;
            if (r < I_IN) { p0_transpose_item(args.in[2], D, NPROJ, Wtin, 0, scr, r, lane); continue; } r -= I_IN;
            if (r < I_OUT) { p0_transpose_item(args.in[9], D, D, Wtout, 0, scr, r, lane); continue; } r -= I_OUT;
            const int e = r / (2 * I_G + I_D); r -= e * (2 * I_G + I_D);
            const float* sg_ = (e < NE) ? args.in[13] + (size_t)e * D * DE : args.in[16]; const float* su_ = (e < NE) ? args.in[14] + (size_t)e * D * DE : args.in[17]; const float* sd_ = (e < NE) ? args.in[15] + (size_t)e * D * DE : args.in[18];
            if (r < I_G) { p0_transpose_item(sg_, D, DE, Wtgu + (size_t)e * 512 * D, 1, scr, r, lane); continue; } r -= I_G;
            if (r < I_G) { p0_transpose_item(su_, D, DE, Wtgu + (size_t)e * 512 * D, 2, scr, r, lane); continue; } r -= I_G;
            p0_transpose_item(sd_, DE, D, Wtd + (size_t)e * D * DE, 0, scr, r, lane);
        }
        for (int m = gw; m < M; m += NGW) rms_row_to_bf16(args.in[0] + (size_t)m * D, args.in[1], U + (size_t)m * D, lane);
    }
    SEAM(0);
    if (IN(1)) {
        pg8::DenseOrder S; S.init(U, Wtin, M, NPROJ, D, G, bx);
        pg8::EpiBf16 E{P, NPROJ};
        pg8::gemm_phase<pg8::EpiBf16, pg8::DenseOrder, true>(lds, D, S, E);
    }
    SEAM(1);
    if (IN(2)) {
        for (int t = gw; t < M; t += NGW) conv_token(P, args.in[3], args.in[7], ymix, t, lane);
        for (int t0 = vcu * 32; t0 < M; t0 += G * 32) attn_naive_block(P, args.in[4], args.in[5], args.in[6], args.in[8], ymix, t0, (float*)lds_raw);
    }
    SEAM(2);
    if (IN(3)) {
        pg8::DenseOrder S; S.init(ymix, Wtout, M, D, D, G, bx);
        pg8::EpiResF32 E{args.in[0], out, D};
        pg8::gemm_phase<pg8::EpiResF32, pg8::DenseOrder, false>(lds, D, S, E);
    }
    SEAM(3);
    if (IN(4)) {
        float* sx = (float*)lds_raw + wave * 1280; float* ssc = sx + 1024; float* sg = ssc + 64; int* sgm = (int*)(sg + 8);
        for (int t = gw; t < M; t += NGW) route_token(out, args.in[10], args.in[11], args.in[12], U, cnt, tok, wl, inv, t, lane, sx, ssc, sg, sgm);
    }
    SEAM(4);
    int ntiles = 0;
    if (IN(5) || IN(6) || IN(7) || IN(8) || IN(9)) build_group_tables(lds, cnt, ntiles);
    const LAS int* tpre = (const LAS int*)(lds + TPRE_OFF); const LAS int* rpre = (const LAS int*)(lds + RPRE_OFF); const LAS int* ncnt = (const LAS int*)(lds + NCNT_OFF);
    const LAS unsigned short* tile_e = (const LAS unsigned short*)(lds + TILEE_OFF);
    if (IN(5)) {
        pg8::GroupedOrder<true> S{tpre, rpre, ncnt, tile_e, (const char*)U, (const char*)Wtgu, tok, (size_t)512 * D * 2, 2, 0, ntiles * 2, G, bx, D};
        pg8::EpiSwiglu E{hb};
        pg8::gemm_phase<pg8::EpiSwiglu, pg8::GroupedOrder<true>, true>(lds, D, S, E);
    }
    SEAM(5);
#pragma unroll 1
    for (int half = 0; half < 2; ++half) {
        if (IN(6 + 2 * half)) {
            pg8::GroupedOrder<false> S{tpre, rpre, ncnt, tile_e, (const char*)hb, (const char*)Wtd, nullptr, (size_t)D * DE * 2, 2, 2 * half, ntiles * 2, G, bx, DE};
            pg8::EpiDown E{Y, wl, half};
            pg8::gemm_phase<pg8::EpiDown, pg8::GroupedOrder<false>, true>(lds, DE, S, E);
        }
        SEAM(6 + 2 * half);
        if (IN(7 + 2 * half)) { for (int t = gw; t < M; t += NGW) combine_token(Y, rpre, inv, out, half, t, lane); }
        SEAM(7 + 2 * half);
    }
#undef IN
#undef SEAM
}

extern "C" void kernel_launch(void* const* d_in, const int* in_sizes, int n_in, void* d_out, int out_size, void* d_ws, size_t ws_size, hipStream_t stream) {
    static int grid = 0;
    if (grid == 0) {
        if (n_in != 19 || in_sizes[0] != M * D || out_size != M * D || ws_size < WS_END) { fprintf(stderr, "kernel_launch: unexpected shapes/ws (n_in %d, ws %zu)\n", n_in, ws_size); grid = -1; return; }
        int dev = 0, cus = 0, per_cu = 0;
        if (hipGetDevice(&dev) != hipSuccess || hipDeviceGetAttribute(&cus, hipDeviceAttributeMultiprocessorCount, dev) != hipSuccess) { grid = -1; return; }
        if (hipFuncSetAttribute((const void*)mega_fwd, hipFuncAttributeMaxDynamicSharedMemorySize, LDS_BYTES) != hipSuccess) { fprintf(stderr, "kernel_launch: hipFuncSetAttribute failed\n"); grid = -1; return; }
        if (hipOccupancyMaxActiveBlocksPerMultiprocessor(&per_cu, (const void*)mega_fwd, NWAVES * 64, LDS_BYTES) != hipSuccess || per_cu < 1) fprintf(stderr, "kernel_launch: occupancy query reports %d\n", per_cu);
        (void)hipGetLastError();
        grid = cus;
    }
    if (grid < 0) return;
    (void)hipMemsetAsync((char*)d_ws + WS_CTL, 0, 1 * MiB, stream);
    Args a{};
    for (int i = 0; i < 19; ++i) a.in[i] = (const float*)d_in[i];
    a.out = (float*)d_out; a.ws = (unsigned char*)d_ws;
#ifndef MK_SPLIT
    a.ph_lo = 0; a.ph_hi = 10;
    hipLaunchKernelGGL(mega_fwd, dim3(grid), dim3(NWAVES * 64), LDS_BYTES, stream, a);
#else
    for (int p = 0; p < 10; ++p) { a.ph_lo = p; a.ph_hi = p + 1; hipLaunchKernelGGL(mega_fwd, dim3(grid), dim3(NWAVES * 64), LDS_BYTES, stream, a); }
#endif
}
```

```cpp
#include <hip/hip_runtime.h>
#include <cstdio>
#include <cstdint>

#define GAS __attribute__((address_space(1)))
#define LAS __attribute__((address_space(3)))
typedef unsigned short bf16_t;
typedef short bf16x8 __attribute__((ext_vector_type(8)));
typedef float f32x16 __attribute__((ext_vector_type(16)));
typedef float f32x4 __attribute__((ext_vector_type(4)));
typedef unsigned u32x4 __attribute__((ext_vector_type(4)));
typedef unsigned v4u __attribute__((ext_vector_type(4)));
typedef GAS unsigned gu32;
typedef GAS unsigned long long gu64;
#define RLX_AGENT __ATOMIC_RELAXED, __HIP_MEMORY_SCOPE_AGENT
#define LDS_WAIT() asm volatile("s_waitcnt lgkmcnt(0)" ::: "memory")
#define VM_WAIT() asm volatile("s_waitcnt vmcnt(0)" ::: "memory")

constexpr int D = 1024, BATCH = 4, SEQ = 4096, M = BATCH * SEQ;
constexpr int DCONV = 512, HD = 64, NH = 8, NKV = 2, DATT = 512, DKV = 128, WIN = 128;
constexpr int NPROJ = 2304;
constexpr int OFF_B = 0, OFF_C = 512, OFF_H = 1024, OFF_Q = 1536, OFF_K = 2048, OFF_V = 2176;
constexpr int NE = 64, TOPK = 8, NG = 8, TOPG = 4, DE = 256;
constexpr float EPS = 1e-6f, RSCALE = 2.5f;
constexpr int NEX = NE + 1;
constexpr int NSLOT = M * TOPK;
constexpr int LISTCAP = M;
constexpr int MAXTILES = 704;

constexpr size_t MiB = 1u << 20;
constexpr size_t WS_CTL = 0;
constexpr size_t WS_TOK = 1 * MiB;
constexpr size_t WS_WL = 5 * MiB;
constexpr size_t WS_RL = 9 * MiB;
constexpr size_t WS_INV = 13 * MiB;
constexpr size_t WS_WR = 13 * MiB + 512 * 1024;
constexpr size_t WS_RSTD = WS_WR + 256 * 1024;
constexpr size_t WS_WTD = 14 * MiB;
constexpr size_t WS_P = 47 * MiB;
constexpr size_t WS_HB = 47 * MiB;
constexpr size_t WS_WTIN = 120 * MiB;
constexpr size_t WS_WTOUT = 125 * MiB;
constexpr size_t WS_WTGU = 127 * MiB;
constexpr size_t WS_U = 192 * MiB;
constexpr size_t WS_YMIX = 224 * MiB;
constexpr size_t WS_Y = 120 * MiB;
constexpr size_t WS_END = 265 * MiB;
constexpr int CW_CNT = 8192, CSTR = 64;
constexpr int CW_BAR = 4096;

constexpr int RING_BYTES = 131072;
constexpr int MISC_OFF = RING_BYTES;
constexpr int TPRE_OFF = MISC_OFF + 128;
constexpr int RPRE_OFF = TPRE_OFF + 272;
constexpr int NCNT_OFF = RPRE_OFF + 272;
constexpr int TILEE_OFF = NCNT_OFF + 272;
constexpr int LDS_BYTES = 147456;
static_assert(TILEE_OFF + MAXTILES * 2 <= LDS_BYTES, "LDS map");

__device__ __forceinline__ unsigned f2bf(float f) { unsigned u = __builtin_bit_cast(unsigned, f); return (u + 0x7fffu + ((u >> 16) & 1u)) >> 16; }
__device__ __forceinline__ unsigned pk2(float lo, float hi) { return f2bf(lo) | (f2bf(hi) << 16); }
__device__ __forceinline__ float bf2f(unsigned short b) { return __builtin_bit_cast(float, (unsigned)b << 16); }
__device__ __forceinline__ float wave_sum(float v) {
#pragma unroll
    for (int o = 1; o < 64; o <<= 1) v += __shfl_xor(v, o);
    return v;
}
__device__ __forceinline__ int crow(int reg, int h) { return (reg & 3) + 8 * (reg >> 2) + 4 * h; }
#define XB_TMO      128
#define XB_XCNT(j)  (256  + 64 * (j))
#define XB_XSUB(j)  (1280 + 64 * (j))
#define XB_XGEN(j)  (2304 + 64 * (j))
#define XB_TOP      3328
#define XB_TOPGEN   3392
#define XCD_BAR_WORDS 3456
#define XB_SPIN_CAP (1u << 18)

__device__ __forceinline__ unsigned xb_ld(unsigned* p)              { return __hip_atomic_load(p, __ATOMIC_RELAXED, __HIP_MEMORY_SCOPE_AGENT); }
__device__ __forceinline__ unsigned xb_add(unsigned* p, unsigned v) { return __hip_atomic_fetch_add(p, v, __ATOMIC_RELAXED, __HIP_MEMORY_SCOPE_AGENT); }
__device__ __forceinline__ unsigned xb_xcc_id() { return (unsigned)__builtin_amdgcn_s_getreg((3 << 11) | 20) & 0xFu; }
#define XB_SPIN(cond, bar) do { unsigned _sp = 0; while (cond) { __builtin_amdgcn_s_sleep(1); \
    if ((++_sp & 255u) == 0u) { if (xb_ld(&(bar)[XB_TMO])) break; if (_sp > XB_SPIN_CAP) { atomicAdd(&(bar)[XB_TMO], 1u); break; } } } } while (0)

struct XcdBarrier {
    unsigned* bar; unsigned x;
    volatile LAS unsigned* st;
};

__device__ __forceinline__ XcdBarrier xcd_barrier_post(unsigned* bar, volatile LAS unsigned* st) {
    XcdBarrier b; b.bar = bar; b.x = xb_xcc_id(); b.st = st;
    if (threadIdx.x == 0) (void)xb_add(&bar[XB_XCNT(b.x)], 1u);
    return b;
}
__device__ __forceinline__ void xcd_barrier_complete(unsigned* bar, unsigned x, unsigned& nloc, unsigned& nx) {
    const unsigned G = gridDim.x * gridDim.y * gridDim.z;
    unsigned sum, cnt, mine, sp = 0u;
    for (;;) {
        sum = 0u; cnt = 0u; mine = 0u;
#pragma unroll
        for (unsigned j = 0; j < 16; ++j) { const unsigned c = xb_ld(&bar[XB_XCNT(j)]); sum += c; cnt += (c > 0u) ? 1u : 0u; mine = (j == x) ? c : mine; }
        if (sum == G) break;
        __builtin_amdgcn_s_sleep(1);
        if ((++sp & 255u) == 0u) { if (xb_ld(&bar[XB_TMO])) break; if (sp > XB_SPIN_CAP) { atomicAdd(&bar[XB_TMO], 1u); break; } }
    }
    nloc = mine > 0u ? mine : 1u; nx = cnt > 0u ? cnt : 1u;
}

__device__ __forceinline__ void xcd_barrier(const XcdBarrier& b) {
    asm volatile("s_waitcnt vmcnt(0)" ::: "memory");
    __syncthreads();
    if (threadIdx.x == 0) {
        unsigned* bar = b.bar;
        __builtin_amdgcn_s_waitcnt(0);
        unsigned nloc = b.st[0], nx = b.st[1];
        if (nloc == 0u) { xcd_barrier_complete(bar, b.x, nloc, nx); b.st[0] = nloc; b.st[1] = nx; }
        const unsigned old = xb_add(&bar[XB_XSUB(b.x)], 1u);
        const unsigned gen = old / nloc;
        if (old + 1u == (gen + 1u) * nloc) {
            __builtin_amdgcn_fence(__ATOMIC_RELEASE, "agent");
            asm volatile("s_waitcnt vmcnt(0)" ::: "memory");
            const unsigned og = xb_add(&bar[XB_TOP], 1u);
            const unsigned tg = og / nx;
            if (og + 1u == (tg + 1u) * nx) xb_add(&bar[XB_TOPGEN], 1u);
            else XB_SPIN(xb_ld(&bar[XB_TOPGEN]) == tg, bar);
            __builtin_amdgcn_fence(__ATOMIC_ACQUIRE, "agent");
            xb_add(&bar[XB_XGEN(b.x)], 1u);
            asm volatile("s_waitcnt vmcnt(0)" ::: "memory");
        } else {
            XB_SPIN(xb_ld(&bar[XB_XGEN(b.x)]) == gen, bar);
            __builtin_amdgcn_fence(__ATOMIC_ACQUIRE, "agent");
            asm volatile("s_waitcnt vmcnt(0)" ::: "memory");
        }
    }
    __syncthreads();
}
namespace pg8 {
#define PG8_LAS __attribute__((address_space(3)))
constexpr int BM = 256, BK = 64, HALF = 128, HTB = HALF * BK * 2  , STAGE_BYTES = 8 * HTB, NXCD = 8, WGM = 8;

__host__ __device__ __forceinline__ int lds_byte(int r, int c) { const int st = (r >> 4) * 2 + (c >> 5), rr = r & 15, cc = c & 31, ob = rr * 64 + cc * 2; return st * 1024 + (ob ^ (((ob >> 9) & 1) << 5)); }
__host__ __device__ __forceinline__ void stage_rc(int b, int& R, int& C) { const int st = b / 1024, sb = b % 1024, swz = sb ^ (((sb >> 9) & 1) << 5); R = (st >> 1) * 16 + swz / 64; C = (st & 1) * 32 + (swz % 64) / 2; }
__host__ __device__ __forceinline__ int perm32(int rho) { const int n = rho >> 4, i = rho & 15; return 8 * (i >> 2) + 4 * n + (i & 3); }

struct Unit { const char* aB; const char* bB; int pm, pn, e, row0, nvalid; };

__device__ __forceinline__ unsigned cvt_pk_bf16(float lo, float hi) { unsigned r; asm volatile("v_cvt_pk_bf16_f32 %0, %1, %2" : "=v"(r) : "v"(lo), "v"(hi)); return r; }

__device__ __forceinline__ int xcd_remap(int L, int nwg) { const int q = nwg / NXCD, r = nwg % NXCD, xcd = L % NXCD, off = L / NXCD; return (xcd < r ? xcd * (q + 1) : r * (q + 1) + (xcd - r) * q) + off; }

struct DenseOrder {
    const char* A; const char* Bt; int nM, nN, nwg, G, c, K;
    __device__ void init(const bf16_t* A_, const bf16_t* Bt_, int M_, int N_, int K_, int G_, int c_) { A = (const char*)A_; Bt = (const char*)Bt_; nM = M_ / BM; nN = N_ / BM; nwg = nM * nN; G = G_; c = c_; K = K_; }
    __device__ __forceinline__ bool next(int i, Unit& u) const {
        const long L = (long)i * G + c; if (L >= nwg) return false;
        const int wgid = xcd_remap((int)L, nwg);
        const int nig = WGM * nN, gid = wgid / nig, fm = gid * WGM, gsz = (nM - fm) < WGM ? (nM - fm) : WGM;
        u.pm = fm + ((wgid % nig) % gsz); u.pn = (wgid % nig) / gsz; u.e = 0; u.row0 = u.pm * BM; u.nvalid = BM;
        u.aB = A + (size_t)u.pm * BM * K * 2; u.bB = Bt + (size_t)u.pn * BM * K * 2; return true;
    }
    __device__ __forceinline__ void a_voff(const Unit&, const int (&R)[2], const int (&C)[2], unsigned (&vo)[2][2]) const {
#pragma unroll
        for (int h = 0; h < 2; ++h)
#pragma unroll
            for (int i = 0; i < 2; ++i) vo[h][i] = (unsigned)((R[i] + HALF * h) * K + C[i]) * 2u;
    }
};

template <class Epi, class Sched, bool ALIGN_EPI>
__device__ __forceinline__ void gemm_phase(PG8_LAS unsigned char* lds, const int K, const Sched& S, const Epi& E) {
    const int tid = threadIdx.x, wid = __builtin_amdgcn_readfirstlane(tid >> 6), lane = tid & 63, wr = wid >> 2, wc = wid & 3, fr = lane & 15, fq = lane >> 4;
    const int nt = K / BK;
    int RA[2], CA[2]; unsigned voffB[2];
#pragma unroll
    for (int i = 0; i < 2; ++i) { int R, C; stage_rc(tid * 16 + i * 8192, R, C); const int Rb = Epi::PERM ? ((R & ~31) + perm32(R & 31)) : R;
        RA[i] = R; CA[i] = C; voffB[i] = (unsigned)(Rb * K + C) * 2u; }
    const size_t kstep = (size_t)(BK * 2);
    const size_t hstep = (size_t)HALF * K * 2;
    const unsigned ldsw = (unsigned)wid * 1024u;
    const int aoff = lds_byte(wr * 64 + fr, fq * 8), boff = lds_byte(wc * 32 + fr, fq * 8);
#define PG8_SA(b, h) (((b) * 2 + (h)) * HTB)
#define PG8_SB(b, h) ((4 + (b) * 2 + (h)) * HTB)
#define PG8_STAGE(bufoff, gbase, voff) do { _Pragma("unroll") for (int _i = 0; _i < 2; ++_i) \
        __builtin_amdgcn_global_load_lds((const unsigned*)((const char*)(gbase) + (voff)[_i]), (PG8_LAS unsigned*)(lds + (bufoff) + ldsw + _i * 8192), 16, 0, 0); } while (0)
#define PG8_LDA(dst, b, h) do { _Pragma("unroll") for (int m = 0; m < 4; ++m) _Pragma("unroll") for (int k = 0; k < 2; ++k) dst[m][k] = *(const PG8_LAS bf16x8*)(lds + PG8_SA(b, h) + aoff + m * 2048 + k * 1024); } while (0)
#define PG8_LDB(dst, b, h) do { _Pragma("unroll") for (int n = 0; n < 2; ++n) _Pragma("unroll") for (int k = 0; k < 2; ++k) dst[n][k] = *(const PG8_LAS bf16x8*)(lds + PG8_SB(b, h) + boff + n * 2048 + k * 1024); } while (0)
#define PG8_MMA(ai, bj, At, Bt) do { __builtin_amdgcn_s_setprio(1); _Pragma("unroll") for (int m = 0; m < 4; ++m) _Pragma("unroll") for (int n = 0; n < 2; ++n) _Pragma("unroll") for (int k = 0; k < 2; ++k) \
        acc[ai][bj][m][n] = __builtin_amdgcn_mfma_f32_16x16x32_bf16(Bt[n][k], At[m][k], acc[ai][bj][m][n], 0, 0, 0); __builtin_amdgcn_s_setprio(0); } while (0)
#define PG8_WAIT_V(n) asm volatile("s_waitcnt vmcnt(" #n ")" ::: "memory")
#define PG8_WAIT_L(n) asm volatile("s_waitcnt lgkmcnt(" #n ")" ::: "memory")
#define PG8_BAR __builtin_amdgcn_s_barrier()
#define PG8_SCHED __builtin_amdgcn_sched_barrier(0)
    Unit cur, nxt; int ui = 0;
    if (!S.next(0, cur)) return;
    unsigned vA[2][2], vN[2][2];
    S.a_voff(cur, RA, CA, vA);
    f32x4 acc[2][2][4][2];
#pragma unroll
    for (int a = 0; a < 2; ++a)
#pragma unroll
        for (int b = 0; b < 2; ++b)
#pragma unroll
            for (int m = 0; m < 4; ++m)
#pragma unroll
                for (int n = 0; n < 2; ++n) acc[a][b][m][n] = (f32x4){0.f, 0.f, 0.f, 0.f};
    bf16x8 At[4][2], B0[2][2], B1[2][2];
    const char* cA = cur.aB; const char* cB = cur.bB;
    PG8_STAGE(PG8_SB(0, 0), cB, voffB); PG8_STAGE(PG8_SB(0, 1), cB + hstep, voffB); PG8_STAGE(PG8_SA(0, 0), cA, vA[0]); PG8_STAGE(PG8_SA(0, 1), cA, vA[1]);
    if (wr == 1) PG8_BAR;
    PG8_WAIT_V(2); PG8_BAR;
    PG8_STAGE(PG8_SB(1, 0), cB + kstep, voffB); PG8_STAGE(PG8_SA(1, 0), cA + kstep, vA[0]); PG8_STAGE(PG8_SB(1, 1), cB + hstep + kstep, voffB);
    PG8_WAIT_V(6); PG8_BAR;
    for (;;) {
        const bool has_next = S.next(ui + 1, nxt);
        const char* nA = has_next ? nxt.aB : cA; const char* nB = has_next ? nxt.bB : cB;
        if (has_next) S.a_voff(nxt, RA, CA, vN);
        else {
#pragma unroll
            for (int h = 0; h < 2; ++h)
#pragma unroll
                for (int i = 0; i < 2; ++i) vN[h][i] = vA[h][i]; }
#pragma unroll 1
        for (int t = 0; t < nt; t += 2) {
            const bool last = (t == nt - 2);
            const char* a1 = cA + (size_t)(t + 1) * kstep;
            const char* a2 = last ? nA : cA + (size_t)(t + 2) * kstep; const char* b2 = last ? nB : cB + (size_t)(t + 2) * kstep;
            const char* a3 = a2 + kstep; const char* b3 = b2 + kstep;
            unsigned w2[2][2];
#pragma unroll
            for (int h = 0; h < 2; ++h)
#pragma unroll
                for (int i = 0; i < 2; ++i) w2[h][i] = last ? vN[h][i] : vA[h][i];
            PG8_LDB(B0, 0, 0); PG8_LDB(B1, 0, 1); PG8_SCHED; PG8_LDA(At, 0, 0); PG8_STAGE(PG8_SA(1, 1), a1, vA[1]);
            PG8_WAIT_V(8); PG8_WAIT_L(0); PG8_BAR; PG8_MMA(0, 0, At, B0); PG8_MMA(0, 1, At, B1); PG8_BAR; PG8_SCHED;
            PG8_LDA(At, 0, 1); PG8_STAGE(PG8_SB(0, 0), b2, voffB); PG8_STAGE(PG8_SB(0, 1), b2 + hstep, voffB); PG8_STAGE(PG8_SA(0, 0), a2, w2[0]);
            PG8_WAIT_V(8); PG8_WAIT_L(0); PG8_BAR; PG8_MMA(1, 0, At, B0); PG8_MMA(1, 1, At, B1); PG8_BAR; PG8_SCHED;
            PG8_LDB(B0, 1, 0); PG8_LDB(B1, 1, 1); PG8_SCHED; PG8_LDA(At, 1, 0); PG8_STAGE(PG8_SA(0, 1), a2, w2[1]);
            PG8_WAIT_V(8); PG8_WAIT_L(0); PG8_BAR; PG8_MMA(0, 0, At, B0); PG8_MMA(0, 1, At, B1); PG8_BAR; PG8_SCHED;
            PG8_LDA(At, 1, 1); PG8_STAGE(PG8_SB(1, 0), b3, voffB); PG8_STAGE(PG8_SB(1, 1), b3 + hstep, voffB); PG8_STAGE(PG8_SA(1, 0), a3, w2[0]);
            PG8_WAIT_V(8); PG8_WAIT_L(0); PG8_BAR; PG8_MMA(1, 0, At, B0); PG8_MMA(1, 1, At, B1); PG8_BAR; PG8_SCHED;
        }
        if constexpr (ALIGN_EPI) { if (wr == 0) PG8_BAR; }
        E(acc, cur, wr, wc, fr, fq);
        if (!has_next) break;
#pragma unroll
        for (int a = 0; a < 2; ++a)
#pragma unroll
            for (int b = 0; b < 2; ++b)
#pragma unroll
                for (int m = 0; m < 4; ++m)
#pragma unroll
                    for (int n = 0; n < 2; ++n) acc[a][b][m][n] = (f32x4){0.f, 0.f, 0.f, 0.f};
        cur = nxt; cA = nA; cB = nB; ++ui;
#pragma unroll
        for (int h = 0; h < 2; ++h)
#pragma unroll
            for (int i = 0; i < 2; ++i) vA[h][i] = vN[h][i];
        if constexpr (ALIGN_EPI) { if (wr == 1) PG8_BAR; }
    }
    PG8_WAIT_V(0);
    if constexpr (!ALIGN_EPI) { if (wr == 0) PG8_BAR; }
    PG8_BAR;
#undef PG8_SA
#undef PG8_SB
#undef PG8_STAGE
#undef PG8_LDA
#undef PG8_LDB
#undef PG8_MMA
#undef PG8_WAIT_V
#undef PG8_WAIT_L
#undef PG8_BAR
#undef PG8_SCHED
}

struct EpiBf16 {
    static constexpr bool PERM = true;
    bf16_t* O; int ldc;
    __device__ __forceinline__ void operator()(const f32x4 (&acc)[2][2][4][2], const Unit& u, int wr, int wc, int fr, int fq) const {
        const int row0 = u.row0 + wr * 64 + fr, col0 = u.pn * BM + wc * 32 + 8 * fq;
#pragma unroll
        for (int ai = 0; ai < 2; ++ai)
#pragma unroll
            for (int m = 0; m < 4; ++m) { bf16_t* rowp = O + (size_t)(row0 + ai * HALF + m * 16) * ldc + col0;
#pragma unroll
                for (int bj = 0; bj < 2; ++bj) { const f32x4 v0 = acc[ai][bj][m][0], v1 = acc[ai][bj][m][1];
                    u32x4 w; w.x = cvt_pk_bf16(v0[0], v0[1]); w.y = cvt_pk_bf16(v0[2], v0[3]); w.z = cvt_pk_bf16(v1[0], v1[1]); w.w = cvt_pk_bf16(v1[2], v1[3]);
                    *(u32x4*)(rowp + bj * HALF) = w; } }
    }
};
struct EpiResF32 {
    static constexpr bool PERM = true;
    const float* base; float* out; bf16_t* xb; int ldc;
    __device__ __forceinline__ void operator()(const f32x4 (&acc)[2][2][4][2], const Unit& u, int wr, int wc, int fr, int fq) const {
        const int row0 = u.row0 + wr * 64 + fr, col0 = u.pn * BM + wc * 32 + 8 * fq;
#pragma unroll
        for (int ai = 0; ai < 2; ++ai)
#pragma unroll
            for (int m = 0; m < 4; ++m) { const size_t off = (size_t)(row0 + ai * HALF + m * 16) * ldc + col0;
#pragma unroll
                for (int bj = 0; bj < 2; ++bj) { const f32x4 b0 = *(const f32x4*)(base + off + bj * HALF), b1 = *(const f32x4*)(base + off + bj * HALF + 4);
                    const f32x4 o0 = b0 + acc[ai][bj][m][0], o1 = b1 + acc[ai][bj][m][1];
                    *(f32x4*)(out + off + bj * HALF) = o0; *(f32x4*)(out + off + bj * HALF + 4) = o1;
                    u32x4 w; w.x = cvt_pk_bf16(o0[0], o0[1]); w.y = cvt_pk_bf16(o0[2], o0[3]); w.z = cvt_pk_bf16(o1[0], o1[1]); w.w = cvt_pk_bf16(o1[2], o1[3]);
                    *(u32x4*)(xb + off + bj * HALF) = w; } }
    }
};
__device__ __forceinline__ float silu_mul(float g, float u) { return g * __builtin_amdgcn_rcpf(1.0f + __expf(-g)) * u; }
struct EpiSwiglu {
    static constexpr bool PERM = true;
    bf16_t* H; const float* rl; const float* rstd2;
    __device__ __forceinline__ void operator()(const f32x4 (&acc)[2][2][4][2], const Unit& u, int wr, int wc, int fr, int fq) const {
        const int rt0 = wr * 64 + fr, col0 = u.pn * HALF + wc * 32 + 8 * fq;
        const float* srow = (u.e < NE ? rl + (size_t)u.e * LISTCAP : rstd2) + u.pm * BM;
#pragma unroll
        for (int ai = 0; ai < 2; ++ai)
#pragma unroll
            for (int m = 0; m < 4; ++m) { const int rt = rt0 + ai * HALF + m * 16;
                if (rt < u.nvalid) { const float s = srow[rt]; const f32x4 g0 = acc[ai][0][m][0] * s, g1 = acc[ai][0][m][1] * s, u0 = acc[ai][1][m][0] * s, u1 = acc[ai][1][m][1] * s;
                    u32x4 w; w.x = cvt_pk_bf16(silu_mul(g0[0], u0[0]), silu_mul(g0[1], u0[1])); w.y = cvt_pk_bf16(silu_mul(g0[2], u0[2]), silu_mul(g0[3], u0[3]));
                    w.z = cvt_pk_bf16(silu_mul(g1[0], u1[0]), silu_mul(g1[1], u1[1])); w.w = cvt_pk_bf16(silu_mul(g1[2], u1[2]), silu_mul(g1[3], u1[3]));
                    *(u32x4*)(H + (size_t)(u.row0 + rt) * DE + col0) = w; } }
    }
};
struct EpiDown {
    static constexpr bool PERM = true;
    bf16_t* Y; const float* wl; int half;
    __device__ __forceinline__ void operator()(const f32x4 (&acc)[2][2][4][2], const Unit& u, int wr, int wc, int fr, int fq) const {
        const int rt0 = wr * 64 + fr, cl0 = (u.pn - 2 * half) * BM + wc * 32 + 8 * fq;
        const float* wrow = wl + (size_t)(u.e < NE ? u.e : 0) * LISTCAP + u.pm * BM;
#pragma unroll
        for (int ai = 0; ai < 2; ++ai)
#pragma unroll
            for (int m = 0; m < 4; ++m) { const int rt = rt0 + ai * HALF + m * 16;
                if (rt < u.nvalid) { const float w = (u.e < NE) ? wrow[rt] : 1.0f; bf16_t* rowp = Y + (size_t)(u.row0 + rt) * 512 + cl0;
#pragma unroll
                    for (int bj = 0; bj < 2; ++bj) { const f32x4 v0 = acc[ai][bj][m][0] * w, v1 = acc[ai][bj][m][1] * w;
                        u32x4 p; p.x = cvt_pk_bf16(v0[0], v0[1]); p.y = cvt_pk_bf16(v0[2], v0[3]); p.z = cvt_pk_bf16(v1[0], v1[1]); p.w = cvt_pk_bf16(v1[2], v1[3]);
                        *(u32x4*)(rowp + bj * HALF) = p; } } }
    }
};

template <bool GATHER> struct GroupedOrder {
    const PG8_LAS int* tpre; const PG8_LAS int* rpre; const PG8_LAS int* ncnt; const PG8_LAS unsigned short* tile_e;
    const char* A; const char* Bt; const int* tok; size_t b_estride; int npn, pn0, nU, G, c, K;
    __device__ __forceinline__ bool next(int i, Unit& u) const {
        const long L = (long)i * G + c; if (L >= nU) return false;
        const int wgid = xcd_remap((int)L, nU), tile = wgid / npn, pnl = wgid % npn;
        const int e = __builtin_amdgcn_readfirstlane((int)tile_e[tile]);
        const int mt = tile - __builtin_amdgcn_readfirstlane(tpre[e]), r0 = __builtin_amdgcn_readfirstlane(rpre[e]) + mt * BM, ne = __builtin_amdgcn_readfirstlane(ncnt[e]);
        u.e = e; u.pm = mt; u.pn = pn0 + pnl; u.row0 = r0; u.nvalid = (ne - mt * BM) < BM ? (ne - mt * BM) : BM;
        u.aB = GATHER ? A : A + (size_t)r0 * K * 2; u.bB = Bt + (size_t)e * b_estride + (size_t)u.pn * BM * K * 2; return true;
    }
    __device__ __forceinline__ void a_voff(const Unit& u, const int (&R)[2], const int (&C)[2], unsigned (&vo)[2][2]) const {
#pragma unroll
        for (int h = 0; h < 2; ++h)
#pragma unroll
            for (int i = 0; i < 2; ++i) { const int rt = R[i] + HALF * h;
                if (GATHER) { int t = 0; if (rt < u.nvalid) t = (u.e < NE) ? tok[(size_t)u.e * LISTCAP + u.pm * BM + rt] : (u.pm * BM + rt);
                    vo[h][i] = (unsigned)(t * K + C[i]) * 2u; }
                else vo[h][i] = (unsigned)(rt * K + C[i]) * 2u; }
    }
};
}

constexpr int NWAVES = 8;
struct Args { const float* in[19]; float* out; unsigned char* ws; int ph_lo, ph_hi; };

template <bool SCALE>
__device__ __forceinline__ void p0_transpose_item(const float* W, int K, int N, bf16_t* WT, int mode, const float* ksc, LAS float* scr, int item, int lane) {
    const int nblk = N / 32, kb = item / nblk, nb = item % nblk, k0 = 64 * kb, n0 = 32 * nb;
    const int rowbase = (mode == 0) ? n0 : ((n0 >> 7) * 256 + (n0 & 127) + (mode == 2 ? 128 : 0));
#pragma unroll 8
    for (int i = 0; i < 32; ++i) { const int kk = 2 * i + (lane >> 5); scr[kk * 33 + (lane & 31)] = W[(size_t)(k0 + kk) * N + n0 + (lane & 31)]; }
    const int c = lane & 7;
    f32x4 s0 = (f32x4){1.f, 1.f, 1.f, 1.f}, s1 = s0;
    if (SCALE) { s0 = *(const f32x4*)(ksc + k0 + 8 * c); s1 = *(const f32x4*)(ksc + k0 + 8 * c + 4); }
    LDS_WAIT(); asm volatile("" ::: "memory");
#pragma unroll
    for (int j = 0; j < 4; ++j) { const int n = (lane >> 3) + 8 * j; const LAS float* s = scr + (8 * c) * 33 + n;
        v4u o; o.x = pk2(s[0 * 33] * s0.x, s[1 * 33] * s0.y); o.y = pk2(s[2 * 33] * s0.z, s[3 * 33] * s0.w); o.z = pk2(s[4 * 33] * s1.x, s[5 * 33] * s1.y); o.w = pk2(s[6 * 33] * s1.z, s[7 * 33] * s1.w);
        *(GAS v4u*)(WT + (size_t)(rowbase + n) * K + k0 + 8 * c) = o; }
    LDS_WAIT(); asm volatile("" ::: "memory");
}
__device__ __forceinline__ void rms_row_to_bf16(const float* xrow, const float* w, bf16_t* orow, int lane) {
    const f32x4* xr = (const f32x4*)xrow + lane; const f32x4* wr = (const f32x4*)w + lane;
    f32x4 v[4]; float s = 0.f;
#pragma unroll
    for (int j = 0; j < 4; ++j) { v[j] = xr[64 * j]; s += (v[j].x * v[j].x + v[j].y * v[j].y) + (v[j].z * v[j].z + v[j].w * v[j].w); }
    const float rstd = 1.0f / sqrtf(wave_sum(s) * (1.0f / D) + EPS);
    unsigned long long* o8 = (unsigned long long*)orow + lane;
#pragma unroll
    for (int j = 0; j < 4; ++j) { const f32x4 ww = wr[64 * j];
        o8[64 * j] = (unsigned long long)pk2(v[j].x * rstd * ww.x, v[j].y * rstd * ww.y) | ((unsigned long long)pk2(v[j].z * rstd * ww.z, v[j].w * rstd * ww.w) << 32); }
}

__device__ __forceinline__ void conv_token(const bf16_t* P, const float* conv_w, const float* nw, bf16_t* ymix, int t, int lane) {
    const int s = t % SEQ, c0 = lane * 8;
    float v[8];
#pragma unroll
    for (int j = 0; j < 8; ++j) v[j] = 0.f;
#pragma unroll
    for (int k = 0; k < 3; ++k) { const int ds = k - 2;
        if (s + ds >= 0) { const bf16_t* row = P + (size_t)(t + ds) * NPROJ; const bf16x8 cg = *(const bf16x8*)(row + OFF_C + c0), hh = *(const bf16x8*)(row + OFF_H + c0);
#pragma unroll
            for (int j = 0; j < 8; ++j) v[j] += conv_w[k * DCONV + c0 + j] * (bf2f((unsigned short)cg[j]) * bf2f((unsigned short)hh[j])); } }
    const bf16x8 bg = *(const bf16x8*)(P + (size_t)t * NPROJ + OFF_B + c0); float ss = 0.f;
#pragma unroll
    for (int j = 0; j < 8; ++j) { v[j] *= bf2f((unsigned short)bg[j]); ss += v[j] * v[j]; }
    const float rstd = 1.0f / sqrtf(wave_sum(ss) * (1.0f / DCONV) + EPS);
    bf16x8 o;
#pragma unroll
    for (int j = 0; j < 8; ++j) o[j] = (short)f2bf(v[j] * rstd * nw[c0 + j]);
    *(bf16x8*)(ymix + (size_t)t * D + c0) = o;
}
constexpr int ATT_VB = 20480;
constexpr int ATT_SSQ = 2 * ATT_VB;
typedef short v4i16_t __attribute__((ext_vector_type(4)));
typedef float f32x2_t __attribute__((ext_vector_type(2))); typedef __bf16 bf16x2_t __attribute__((ext_vector_type(2)));
__device__ __forceinline__ unsigned cvtpk_s(float lo, float hi) { f32x2_t v = {lo, hi}; bf16x2_t b = __builtin_convertvector(v, bf16x2_t); return __builtin_bit_cast(unsigned, b); }
__device__ __forceinline__ v4i16_t vtr(const LAS unsigned char* p) { return __builtin_amdgcn_ds_read_tr16_b64_v4i16((LAS v4i16_t*)p); }
__device__ __forceinline__ void norm_frags(const bf16x8 (&raw)[4], const float* nw, int hf, float extra, bf16x8 (&out)[4]) {
    float ss = 0.f;
#pragma unroll
    for (int s = 0; s < 4; ++s)
#pragma unroll
        for (int j = 0; j < 8; ++j) { const float f = bf2f((unsigned short)raw[s][j]); ss += f * f; }
    ss += __shfl_xor(ss, 32);
    const float rs = extra / sqrtf(ss * (1.0f / 64) + EPS);
#pragma unroll
    for (int s = 0; s < 4; ++s) { const f32x4 w0 = *(const f32x4*)(nw + 16 * s + 8 * hf), w1 = *(const f32x4*)(nw + 16 * s + 8 * hf + 4);
        u32x4 o;
        o.x = cvtpk_s(bf2f((unsigned short)raw[s][0]) * rs * w0.x, bf2f((unsigned short)raw[s][1]) * rs * w0.y); o.y = cvtpk_s(bf2f((unsigned short)raw[s][2]) * rs * w0.z, bf2f((unsigned short)raw[s][3]) * rs * w0.w);
        o.z = cvtpk_s(bf2f((unsigned short)raw[s][4]) * rs * w1.x, bf2f((unsigned short)raw[s][5]) * rs * w1.y); o.w = cvtpk_s(bf2f((unsigned short)raw[s][6]) * rs * w1.z, bf2f((unsigned short)raw[s][7]) * rs * w1.w);
        out[s] = __builtin_bit_cast(bf16x8, o); }
}
__device__ __forceinline__ void attn_unit(const bf16_t* P, const float* qnw, const float* knw, const float* sinks, const float* anw, bf16_t* ymix, int t0, LAS unsigned char* lds, int wave, int lane) {
    constexpr float LOG2E = 1.4426950408889634f;
    const int tid = threadIdx.x, s0 = t0 % SEQ, kb0 = t0 - 128;
    for (int i = tid; i < 2560; i += NWAVES * 64) { const int piece = i & 7, key = (i >> 3) % 160, kvh = i / 1280; int row = kb0 + key; row = row < 0 ? 0 : row;
        const u32x4 v = *(const u32x4*)(P + (size_t)row * NPROJ + OFF_V + kvh * 64 + piece * 8); *(LAS u32x4*)(lds + kvh * ATT_VB + key * 128 + piece * 16) = v; }
    const int h = wave, kvh = h >> 2, r = lane & 31, hf = lane >> 5;
    bf16x8 qf[4];
    { const bf16_t* qp = P + (size_t)(t0 + r) * NPROJ + OFF_Q + h * 64 + 8 * hf; bf16x8 raw[4];
#pragma unroll
      for (int s = 0; s < 4; ++s) raw[s] = *(const bf16x8*)(qp + 16 * s);
      norm_frags(raw, qnw, hf, 0.125f * LOG2E, qf); }
    const float slope2 = exp2f(-(float)(h + 1)) * LOG2E, sink2 = sinks[h] * LOG2E;
    const int jmin = (128 - s0) > 0 ? (128 - s0) : 0;
    const int dmax = (r + 128 - jmin) < (WIN - 1) ? (r + 128 - jmin) : (WIN - 1);
    float mx = sink2;
    f32x16 p[5];
#pragma unroll
    for (int kb = 0; kb < 5; ++kb) { int row = kb0 + 32 * kb + r; row = row < 0 ? 0 : row;
        const bf16_t* kp = P + (size_t)row * NPROJ + OFF_K + kvh * 64 + 8 * hf; bf16x8 raw[4], kf[4];
#pragma unroll
        for (int s = 0; s < 4; ++s) raw[s] = *(const bf16x8*)(kp + 16 * s);
        norm_frags(raw, knw, hf, 1.0f, kf);
#pragma unroll
        for (int i = 0; i < 16; ++i) p[kb][i] = 0.f;
#pragma unroll
        for (int s = 0; s < 4; ++s) p[kb] = __builtin_amdgcn_mfma_f32_32x32x16_bf16(kf[s], qf[s], p[kb], 0, 0, 0);
        int bk = r + 128 - 32 * kb - 4 * hf; asm volatile("" : "+v"(bk));
        const float sb = slope2 * (float)bk;
#pragma unroll
        for (int i = 0; i < 16; ++i) { const int ci = (i & 3) + 8 * (i >> 2); const int dist = bk - ci; const bool valid = (unsigned)dist <= (unsigned)dmax;
            const float v = valid ? p[kb][i] + (slope2 * (float)ci - sb) : -INFINITY; p[kb][i] = v; mx = fmaxf(mx, v); } }
    mx = fmaxf(mx, __shfl_xor(mx, 32));
    float l = 0.f;
#pragma unroll
    for (int kb = 0; kb < 5; ++kb)
#pragma unroll
        for (int i = 0; i < 16; ++i) { const float e = exp2f(p[kb][i] - mx); p[kb][i] = e; l += e; }
    l += __shfl_xor(l, 32); l += exp2f(sink2 - mx);
    __syncthreads();
    f32x16 o[2];
#pragma unroll
    for (int i = 0; i < 16; ++i) { o[0][i] = 0.f; o[1][i] = 0.f; }
    { const int i16 = lane & 15, tq = i16 >> 2, tp = i16 & 3, blk = (lane >> 4) & 1;
      const LAS unsigned char* vb = lds + kvh * ATT_VB + (4 * hf + tq) * 128 + (16 * blk + 4 * tp) * 2;
#pragma unroll
      for (int kb = 0; kb < 5; ++kb)
#pragma unroll
          for (int sp = 0; sp < 2; ++sp) { u32x4 pw;
              pw.x = cvtpk_s(p[kb][8 * sp + 0], p[kb][8 * sp + 1]); pw.y = cvtpk_s(p[kb][8 * sp + 2], p[kb][8 * sp + 3]); pw.z = cvtpk_s(p[kb][8 * sp + 4], p[kb][8 * sp + 5]); pw.w = cvtpk_s(p[kb][8 * sp + 6], p[kb][8 * sp + 7]);
              const bf16x8 pf = __builtin_bit_cast(bf16x8, pw);
#pragma unroll
              for (int db = 0; db < 2; ++db) { const LAS unsigned char* a = vb + (32 * kb + 16 * sp) * 128 + db * 64;
                  const v4i16_t lo = vtr(a), hi = vtr(a + 8 * 128);
                  const bf16x8 vf = (bf16x8){lo[0], lo[1], lo[2], lo[3], hi[0], hi[1], hi[2], hi[3]};
                  o[db] = __builtin_amdgcn_mfma_f32_32x32x16_bf16(vf, pf, o[db], 0, 0, 0); } } }
    const float il = 1.0f / l; float ss = 0.f;
#pragma unroll
    for (int db = 0; db < 2; ++db)
#pragma unroll
        for (int i = 0; i < 16; ++i) { o[db][i] *= il; ss += o[db][i] * o[db][i]; }
    ss += __shfl_xor(ss, 32);
    LAS float* ssq = (LAS float*)(lds + ATT_SSQ);
    if (hf == 0) ssq[r * 8 + h] = ss;
    __syncthreads();
    float tot = 0.f;
#pragma unroll
    for (int hh = 0; hh < 8; ++hh) tot += ssq[r * 8 + hh];
    const float rstd = 1.0f / sqrtf(tot * (1.0f / DATT) + EPS);
    bf16_t* op = ymix + (size_t)(t0 + r) * D + DCONV + h * 64 + 4 * hf;
#pragma unroll
    for (int db = 0; db < 2; ++db)
#pragma unroll
        for (int g = 0; g < 4; ++g) { const f32x4 w = *(const f32x4*)(anw + h * 64 + db * 32 + 8 * g + 4 * hf);
            const unsigned lo = cvtpk_s(o[db][4 * g] * rstd * w.x, o[db][4 * g + 1] * rstd * w.y), hi = cvtpk_s(o[db][4 * g + 2] * rstd * w.z, o[db][4 * g + 3] * rstd * w.w);
            *(unsigned long long*)(op + db * 32 + 8 * g) = (unsigned long long)lo | ((unsigned long long)hi << 32); }
    __syncthreads();
}

__device__ __forceinline__ void route_task(const float* x1, const bf16_t* Wrh, const bf16_t* Wrl, const float* rbias, float* rstd2, unsigned* cnt, int* tok, float* wl, float* rl, int* inv,
                                           int t0, int lane, LAS float* lg  , LAS float* srs  , LAS float* ssc  , LAS float* sg  , LAS int* sgm  ) {
    const int row = lane & 15, kg = lane >> 4;
    const float* xp = x1 + (size_t)(t0 + row) * D + 8 * kg;
    const bf16_t* bh = Wrh + (size_t)row * D + 8 * kg; const bf16_t* bl = Wrl + (size_t)row * D + 8 * kg;
    f32x4 acc[4]; float ss = 0.f;
#pragma unroll
    for (int nb = 0; nb < 4; ++nb) acc[nb] = (f32x4){0.f, 0.f, 0.f, 0.f};
#pragma unroll 2
    for (int s = 0; s < 32; ++s) {
        const f32x4 v0 = *(const f32x4*)(xp + 32 * s), v1 = *(const f32x4*)(xp + 32 * s + 4);
        ss += (v0.x * v0.x + v0.y * v0.y) + (v0.z * v0.z + v0.w * v0.w) + (v1.x * v1.x + v1.y * v1.y) + (v1.z * v1.z + v1.w * v1.w);
        u32x4 hw, lw;
        hw.x = cvtpk_s(v0.x, v0.y); hw.y = cvtpk_s(v0.z, v0.w); hw.z = cvtpk_s(v1.x, v1.y); hw.w = cvtpk_s(v1.z, v1.w);
        lw.x = cvtpk_s(v0.x - __builtin_bit_cast(float, hw.x << 16), v0.y - __builtin_bit_cast(float, hw.x & 0xffff0000u));
        lw.y = cvtpk_s(v0.z - __builtin_bit_cast(float, hw.y << 16), v0.w - __builtin_bit_cast(float, hw.y & 0xffff0000u));
        lw.z = cvtpk_s(v1.x - __builtin_bit_cast(float, hw.z << 16), v1.y - __builtin_bit_cast(float, hw.z & 0xffff0000u));
        lw.w = cvtpk_s(v1.z - __builtin_bit_cast(float, hw.w << 16), v1.w - __builtin_bit_cast(float, hw.w & 0xffff0000u));
        const bf16x8 xh = __builtin_bit_cast(bf16x8, hw), xl = __builtin_bit_cast(bf16x8, lw);
#pragma unroll
        for (int nb = 0; nb < 4; ++nb) { const bf16x8 wh = *(const bf16x8*)(bh + (size_t)nb * 16 * D + 32 * s), wlo = *(const bf16x8*)(bl + (size_t)nb * 16 * D + 32 * s);
            acc[nb] = __builtin_amdgcn_mfma_f32_16x16x32_bf16(xh, wh, acc[nb], 0, 0, 0);
            acc[nb] = __builtin_amdgcn_mfma_f32_16x16x32_bf16(xl, wh, acc[nb], 0, 0, 0);
            acc[nb] = __builtin_amdgcn_mfma_f32_16x16x32_bf16(xh, wlo, acc[nb], 0, 0, 0); }
    }
    ss += __shfl_xor(ss, 16); ss += __shfl_xor(ss, 32);
    const float rstd = 1.0f / sqrtf(ss * (1.0f / D) + EPS);
    if (kg == 0) { rstd2[t0 + row] = rstd; srs[row] = rstd; }
#pragma unroll
    for (int nb = 0; nb < 4; ++nb)
#pragma unroll
        for (int i = 0; i < 4; ++i) lg[(4 * kg + i) * 64 + 16 * nb + row] = acc[nb][i];
    LDS_WAIT(); asm volatile("" ::: "memory");
    const float bias = rbias[lane];
    unsigned selmask = 0u;
    LAS unsigned long long* sbal = (LAS unsigned long long*)(sgm + 8);
#pragma unroll 1
    for (int j = 0; j < 16; ++j) {
        const float rs = srs[j];
        const float logit = lg[j * 64 + lane] * rs;
        const float score = 1.0f / (1.0f + __expf(-logit)), biased = score + bias;
        ssc[lane] = biased; LDS_WAIT(); asm volatile("" ::: "memory");
        if (lane < 8) { float m1 = -INFINITY, m2 = -INFINITY;
            for (int q = 0; q < 8; ++q) { const float z = ssc[lane * 8 + q]; if (z > m1) { m2 = m1; m1 = z; } else if (z > m2) m2 = z; }
            sg[lane] = m1 + m2; }
        LDS_WAIT(); asm volatile("" ::: "memory");
        if (lane < 8) { const float g = sg[lane]; int c = 0;
            for (int q = 0; q < 8; ++q) { const float z = sg[q]; c += (z > g) || (z == g && q < lane); }
            sgm[lane] = c < TOPG; }
        LDS_WAIT(); asm volatile("" ::: "memory");
        const bool gsel = sgm[lane >> 3] != 0; const float mval = gsel ? biased : -INFINITY; int rank = 0;
#pragma unroll
        for (int q = 0; q < 64; ++q) { const float z = __builtin_bit_cast(float, __builtin_amdgcn_readlane(__builtin_bit_cast(int, mval), q)); rank += ((z > mval) || (z == mval && q < lane)) ? 1 : 0; }
        const bool sel = gsel && rank < TOPK;
        const float wsum = wave_sum(sel ? score : 0.f);
        const unsigned long long bal = __ballot(sel);
        lg[j * 64 + lane] = score / wsum * RSCALE;
        if (lane == 0) sbal[j] = bal;
        if (sel) selmask |= 1u << j;
        LDS_WAIT(); asm volatile("" ::: "memory");
    }
    const int nsel = __popc(selmask);
    unsigned base = 0u; if (nsel) base = atomicAdd(&cnt[lane * CSTR], (unsigned)nsel);
#pragma unroll 1
    for (int j = 0; j < 16; ++j) if ((selmask >> j) & 1u) {
        const unsigned pos = base + (unsigned)__popc(selmask & ((1u << j) - 1u)); const size_t li = (size_t)lane * LISTCAP + pos;
        const int k = __popcll(sbal[j] & ((1ull << lane) - 1ull));
        tok[li] = t0 + j; wl[li] = lg[j * 64 + lane]; rl[li] = srs[j]; inv[(size_t)(t0 + j) * TOPK + k] = (lane << 16) | (int)pos; }
    LDS_WAIT(); asm volatile("" ::: "memory");
}

__device__ __forceinline__ void build_group_tables(LAS unsigned char* lds, const unsigned* cnt, int& ntiles) {
    LAS int* tpre = (LAS int*)(lds + TPRE_OFF); LAS int* rpre = (LAS int*)(lds + RPRE_OFF); LAS int* ncnt = (LAS int*)(lds + NCNT_OFF); LAS unsigned short* tile_e = (LAS unsigned short*)(lds + TILEE_OFF);
    if (threadIdx.x == 0) { int tp = 0, rp = 0;
        for (int e = 0; e < NEX; ++e) { const int n = (e < NE) ? (int)cnt[e * CSTR] : M; tpre[e] = tp; rpre[e] = rp; ncnt[e] = n; tp += (n + 255) >> 8; rp += n; }
        tpre[NEX] = tp; rpre[NEX] = rp; ncnt[NEX] = 0; }
    __syncthreads();
    ntiles = tpre[NEX];
    for (int e = threadIdx.x >> 3; e < NEX; e += 64) { const int a = tpre[e], b = tpre[e + 1]; for (int t = a + (threadIdx.x & 7); t < b; t += 8) tile_e[t] = (unsigned short)e; }
    __syncthreads();
}

__device__ __forceinline__ void combine_token(const bf16_t* y, const LAS int* rpre, const int* inv, float* out, float* outw, int half, int t, int tw, int lane) {
    float a[8];
#pragma unroll
    for (int j = 0; j < 8; ++j) a[j] = 0.f;
#pragma unroll
    for (int k = 0; k < TOPK; ++k) { const int ip = inv[(size_t)t * TOPK + k]; const int row = rpre[ip >> 16] + (ip & 0xffff);
        const bf16x8 v = *(const bf16x8*)(y + (size_t)row * 512 + lane * 8);
#pragma unroll
        for (int j = 0; j < 8; ++j) a[j] += bf2f((unsigned short)v[j]); }
    { const bf16x8 v = *(const bf16x8*)(y + (size_t)(NSLOT + t) * 512 + lane * 8);
#pragma unroll
      for (int j = 0; j < 8; ++j) a[j] += bf2f((unsigned short)v[j]); }
    float* o = out + (size_t)t * D + half * 512 + lane * 8;
    f32x4 o0 = *(f32x4*)o, o1 = *(f32x4*)(o + 4);
    o0.x += a[0]; o0.y += a[1]; o0.z += a[2]; o0.w += a[3]; o1.x += a[4]; o1.y += a[5]; o1.z += a[6]; o1.w += a[7];
    float* ow = outw + (size_t)tw * D + half * 512 + lane * 8;
    *(f32x4*)ow = o0; *(f32x4*)(ow + 4) = o1;
}

#ifndef REP_MASK
#define REP_MASK 0
#endif
#define REPS(k) (1 + ((REP_MASK >> (k)) & 1))
constexpr int N_PHASES = 11;
__global__ void __launch_bounds__(NWAVES * 64, 2) mega_fwd(Args args) {
    extern __shared__ __attribute__((aligned(16))) unsigned char lds_raw[];
    LAS unsigned char* lds = (LAS unsigned char*)lds_raw;
    volatile LAS unsigned* MISC = (volatile LAS unsigned*)(lds + MISC_OFF);
    const int tid = threadIdx.x, lane = tid & 63, wave = __builtin_amdgcn_readfirstlane(tid >> 6);
    const int G = gridDim.x; const int bx = blockIdx.x; const int vcu = (G % 8 == 0) ? (bx % 8) * (G / 8) + bx / 8 : bx;
    unsigned char* ws = args.ws;
    gu32* ctl = (gu32*)(ws + WS_CTL);
    float* out = args.out;
    unsigned* cnt = (unsigned*)(ws + WS_CTL) + CW_CNT;
    int* tok = (int*)(ws + WS_TOK); float* wl = (float*)(ws + WS_WL); int* inv = (int*)(ws + WS_INV);
    bf16_t* Wtd = (bf16_t*)(ws + WS_WTD); bf16_t* P = (bf16_t*)(ws + WS_P); bf16_t* hb = (bf16_t*)(ws + WS_HB); bf16_t* Wtin = (bf16_t*)(ws + WS_WTIN);
    bf16_t* Wtout = (bf16_t*)(ws + WS_WTOUT); bf16_t* Wtgu = (bf16_t*)(ws + WS_WTGU); bf16_t* U = (bf16_t*)(ws + WS_U); bf16_t* ymix = (bf16_t*)(ws + WS_YMIX); bf16_t* Y = (bf16_t*)(ws + WS_Y);

    for (int u = tid; u < 32; u += NWAVES * 64) ((LAS unsigned*)(lds + MISC_OFF))[u] = 0u;
    __syncthreads();
    const int lo = args.ph_lo, hi = args.ph_hi;
    const bool use_bar = (hi - lo) > 1;
    XcdBarrier bar; bar.bar = (unsigned*)(ctl + CW_BAR); bar.x = 0; bar.st = nullptr;
    if (use_bar) bar = xcd_barrier_post((unsigned*)(ctl + CW_BAR), MISC + 8);
#define IN(k) (lo <= (k) && (k) < hi)
#define SEAM(k) do { if (IN(k) && IN((k) + 1)) xcd_barrier(bar); } while (0)
    const int gw = vcu * NWAVES + wave, NGW = G * NWAVES;

    if (IN(0)) for (int rep_ = 0; rep_ < REPS(0); ++rep_) {
        LAS float* scr = (LAS float*)(lds + wave * 16384);
        constexpr int I_IN = (D / 64) * (NPROJ / 32), I_OUT = (D / 64) * (D / 32), I_G = (D / 64) * (DE / 32), I_D = (DE / 64) * (D / 32);
        constexpr int NITEMS = I_IN + I_OUT + NEX * (2 * I_G + I_D);
        for (int it = gw; it < NITEMS; it += NGW) {
            int r = it;
            if (r < I_IN) { p0_transpose_item<false>(args.in[2], D, NPROJ, Wtin, 0, nullptr, scr, r, lane); continue; } r -= I_IN;
            if (r < I_OUT) { p0_transpose_item<false>(args.in[9], D, D, Wtout, 0, nullptr, scr, r, lane); continue; } r -= I_OUT;
            const int e = r / (2 * I_G + I_D); r -= e * (2 * I_G + I_D);
            const float* sg_ = (e < NE) ? args.in[13] + (size_t)e * D * DE : args.in[16]; const float* su_ = (e < NE) ? args.in[14] + (size_t)e * D * DE : args.in[17]; const float* sd_ = (e < NE) ? args.in[15] + (size_t)e * D * DE : args.in[18];
            if (r < I_G) { p0_transpose_item<true>(sg_, D, DE, Wtgu + (size_t)e * 512 * D, 1, args.in[10], scr, r, lane); continue; } r -= I_G;
            if (r < I_G) { p0_transpose_item<true>(su_, D, DE, Wtgu + (size_t)e * 512 * D, 2, args.in[10], scr, r, lane); continue; } r -= I_G;
            p0_transpose_item<false>(sd_, DE, D, Wtd + (size_t)e * D * DE, 0, nullptr, scr, r, lane);
        }
        { bf16_t* Wr = (bf16_t*)(ws + WS_WR); const float* wrt = args.in[11]; const float* fw = args.in[10];
          for (int i = (vcu * NWAVES + wave) * 64 + lane; i < NE * (D / 8); i += NGW * 64) { const int e = i & 63, k8 = (i >> 6) * 8; unsigned hh[4], ll[4];
#pragma unroll
              for (int j = 0; j < 4; ++j) { const float a = wrt[(size_t)(k8 + 2 * j) * NE + e] * fw[k8 + 2 * j], b = wrt[(size_t)(k8 + 2 * j + 1) * NE + e] * fw[k8 + 2 * j + 1];
                  const unsigned ha = f2bf(a), hb2 = f2bf(b); hh[j] = ha | (hb2 << 16); ll[j] = f2bf(a - bf2f((unsigned short)ha)) | (f2bf(b - bf2f((unsigned short)hb2)) << 16); }
              *(v4u*)(Wr + (size_t)e * D + k8) = (v4u){hh[0], hh[1], hh[2], hh[3]}; *(v4u*)(Wr + (size_t)NE * D + (size_t)e * D + k8) = (v4u){ll[0], ll[1], ll[2], ll[3]}; } }
        for (int m = gw; m < M; m += NGW) rms_row_to_bf16(args.in[0] + (size_t)m * D, args.in[1], U + (size_t)m * D, lane);
    }
    SEAM(0);
    if (IN(1)) for (int rep_ = 0; rep_ < REPS(1); ++rep_) {
        pg8::DenseOrder S; S.init(U, Wtin, M, NPROJ, D, G, bx);
        pg8::EpiBf16 E{P, NPROJ};
        pg8::gemm_phase<pg8::EpiBf16, pg8::DenseOrder, true>(lds, D, S, E);
    }
    SEAM(1);
    if (IN(2)) for (int rep_ = 0; rep_ < REPS(2); ++rep_) {
        for (int t0 = vcu * 32; t0 < M; t0 += G * 32) {
#pragma unroll 1
            for (int i = 0; i < 4; ++i) conv_token(P, args.in[3], args.in[7], ymix, t0 + wave * 4 + i, lane);
            attn_unit(P, args.in[4], args.in[5], args.in[6], args.in[8], ymix, t0, lds, wave, lane);
        }
    }
    SEAM(2);
    if (IN(3)) for (int rep_ = 0; rep_ < REPS(3); ++rep_) {
        pg8::DenseOrder S; S.init(ymix, Wtout, M, D, D, G, bx);
        pg8::EpiResF32 E{args.in[0], out, U, D};
        pg8::gemm_phase<pg8::EpiResF32, pg8::DenseOrder, false>(lds, D, S, E);
    }
    SEAM(3);
    if (IN(4)) for (int rep_ = 0; rep_ < REPS(4); ++rep_) {
        if (wave < 4) {
            LAS float* lg = (LAS float*)(lds + wave * 8192); LAS float* srs = lg + 1024; LAS float* ssc = srs + 16; LAS float* sg = ssc + 64; LAS int* sgm = (LAS int*)(sg + 8);
            const bf16_t* Wr = (const bf16_t*)(ws + WS_WR); float* rstd2 = (float*)(ws + WS_RSTD); float* rl = (float*)(ws + WS_RL);
            if (rep_ == 0) { for (int task = wave * G + vcu; task < M / 16; task += 4 * G) route_task(out, Wr, Wr + (size_t)NE * D, args.in[12], rstd2, cnt, tok, wl, rl, inv, task * 16, lane, lg, srs, ssc, sg, sgm); }
            else { unsigned char* dz = ws + WS_HB;
                for (int task = wave * G + vcu; task < M / 16; task += 4 * G) route_task(out, Wr, Wr + (size_t)NE * D, args.in[12], (float*)(dz + 32 * MiB), cnt + 8192, (int*)dz, (float*)(dz + 8 * MiB), (float*)(dz + 24 * MiB), (int*)(dz + 16 * MiB), task * 16, lane, lg, srs, ssc, sg, sgm); }
        }
    }
    SEAM(4);
    int ntiles = 0;
    if (IN(5) || IN(6) || IN(7) || IN(8) || IN(9)) build_group_tables(lds, cnt, ntiles);
    const LAS int* tpre = (const LAS int*)(lds + TPRE_OFF); const LAS int* rpre = (const LAS int*)(lds + RPRE_OFF); const LAS int* ncnt = (const LAS int*)(lds + NCNT_OFF);
    const LAS unsigned short* tile_e = (const LAS unsigned short*)(lds + TILEE_OFF);
    if (IN(5)) for (int rep_ = 0; rep_ < REPS(5); ++rep_) {
        pg8::GroupedOrder<true> S{tpre, rpre, ncnt, tile_e, (const char*)U, (const char*)Wtgu, tok, (size_t)512 * D * 2, 2, 0, ntiles * 2, G, bx, D};
        pg8::EpiSwiglu E{hb, (const float*)(ws + WS_RL), (const float*)(ws + WS_RSTD)};
        pg8::gemm_phase<pg8::EpiSwiglu, pg8::GroupedOrder<true>, true>(lds, D, S, E);
    }
    SEAM(5);
#pragma unroll 1
    for (int half = 0; half < 2; ++half) {
        if (IN(6 + 2 * half)) for (int rep_ = 0; rep_ < REPS(6 + 2 * half); ++rep_) {
            pg8::GroupedOrder<false> S{tpre, rpre, ncnt, tile_e, (const char*)hb, (const char*)Wtd, nullptr, (size_t)D * DE * 2, 2, 2 * half, ntiles * 2, G, bx, DE};
            pg8::EpiDown E{Y, wl, half};
            pg8::gemm_phase<pg8::EpiDown, pg8::GroupedOrder<false>, true>(lds, DE, S, E);
        }
        SEAM(6 + 2 * half);
        if (IN(7 + 2 * half)) for (int rep_ = 0; rep_ < REPS(7 + 2 * half); ++rep_) { float* ow = rep_ == 0 ? out : (float*)(ws + WS_END); for (int t = gw; t < M; t += NGW) combine_token(Y, rpre, inv, out, ow, half, t, rep_ == 0 ? t : (t & 1023), lane); }
        SEAM(7 + 2 * half);
    }
#undef IN
#undef SEAM
}

extern "C" void kernel_launch(void* const* d_in, const int* in_sizes, int n_in, void* d_out, int out_size, void* d_ws, size_t ws_size, hipStream_t stream) {
    static int grid = 0;
    if (grid == 0) {
        if (n_in != 19 || in_sizes[0] != M * D || out_size != M * D || ws_size < WS_END) { fprintf(stderr, "kernel_launch: unexpected shapes/ws (n_in %d, ws %zu)\n", n_in, ws_size); grid = -1; return; }
        int dev = 0, cus = 0, per_cu = 0;
        if (hipGetDevice(&dev) != hipSuccess || hipDeviceGetAttribute(&cus, hipDeviceAttributeMultiprocessorCount, dev) != hipSuccess) { grid = -1; return; }
        if (hipFuncSetAttribute((const void*)mega_fwd, hipFuncAttributeMaxDynamicSharedMemorySize, LDS_BYTES) != hipSuccess) { fprintf(stderr, "kernel_launch: hipFuncSetAttribute failed\n"); grid = -1; return; }
        if (hipOccupancyMaxActiveBlocksPerMultiprocessor(&per_cu, (const void*)mega_fwd, NWAVES * 64, LDS_BYTES) != hipSuccess || per_cu < 1) fprintf(stderr, "kernel_launch: occupancy query reports %d\n", per_cu);
        (void)hipGetLastError();
        grid = cus;
    }
    if (grid < 0) return;
    (void)hipMemsetAsync((char*)d_ws + WS_CTL, 0, 1 * MiB, stream);
    Args a{};
    for (int i = 0; i < 19; ++i) a.in[i] = (const float*)d_in[i];
    a.out = (float*)d_out; a.ws = (unsigned char*)d_ws;
#ifndef MK_SPLIT
    a.ph_lo = 0; a.ph_hi = 10;
    hipLaunchKernelGGL(mega_fwd, dim3(grid), dim3(NWAVES * 64), LDS_BYTES, stream, a);
#else
    for (int p = 0; p < 10; ++p) { a.ph_lo = p; a.ph_hi = p + 1; hipLaunchKernelGGL(mega_fwd, dim3(grid), dim3(NWAVES * 64), LDS_BYTES, stream, a); }
#endif
}
```

```cpp
#include <hip/hip_runtime.h>
#include <cstdio>
#include <cstdint>

#define GAS __attribute__((address_space(1)))
#define LAS __attribute__((address_space(3)))
typedef unsigned short bf16_t;
typedef short bf16x8 __attribute__((ext_vector_type(8)));
typedef float f32x16 __attribute__((ext_vector_type(16)));
typedef float f32x4 __attribute__((ext_vector_type(4)));
typedef unsigned u32x4 __attribute__((ext_vector_type(4)));
typedef unsigned v4u __attribute__((ext_vector_type(4)));
typedef GAS unsigned gu32;
typedef GAS unsigned long long gu64;
#define RLX_AGENT __ATOMIC_RELAXED, __HIP_MEMORY_SCOPE_AGENT
#define LDS_WAIT() asm volatile("s_waitcnt lgkmcnt(0)" ::: "memory")
#define VM_WAIT() asm volatile("s_waitcnt vmcnt(0)" ::: "memory")

constexpr int D = 1024, BATCH = 4, SEQ = 4096, M = BATCH * SEQ;
constexpr int DCONV = 512, HD = 64, NH = 8, NKV = 2, DATT = 512, DKV = 128, WIN = 128;
constexpr int NPROJ = 2304;
constexpr int OFF_B = 0, OFF_C = 512, OFF_H = 1024, OFF_Q = 1536, OFF_K = 2048, OFF_V = 2176;
constexpr int NE = 64, TOPK = 8, NG = 8, TOPG = 4, DE = 256;
constexpr float EPS = 1e-6f, RSCALE = 2.5f, YSCALE = 32.0f;
constexpr float GU_SCALE = 32.0f, DN_SCALE = 16.0f;
constexpr int NEX = NE + 1;
constexpr int NSLOT = M * TOPK;
constexpr int LISTCAP = M;
constexpr int MAXTILES = 704;

constexpr size_t MiB = 1u << 20;
constexpr size_t WS_CTL = 0;
constexpr size_t WS_TOK = 1 * MiB;
constexpr size_t WS_WL = 5 * MiB;
constexpr size_t WS_RL = 9 * MiB;
constexpr size_t WS_INV = 13 * MiB;
constexpr size_t WS_WR = 13 * MiB + 512 * 1024;
constexpr size_t WS_RSTD = WS_WR + 256 * 1024;
constexpr size_t WS_WTD = 14 * MiB;
constexpr size_t WS_P = 47 * MiB;
constexpr size_t WS_HB = 47 * MiB;
constexpr size_t WS_WTIN = 120 * MiB;
constexpr size_t WS_WTOUT = 125 * MiB;
constexpr size_t WS_WTGU = 127 * MiB;
constexpr size_t WS_U = 192 * MiB;
constexpr size_t WS_YMIX = 224 * MiB;
constexpr size_t WS_Y = 120 * MiB;
constexpr size_t WS_END = 265 * MiB;
constexpr int CW_CNT = 8192, CSTR = 64;
constexpr int CW_BAR = 4096;

constexpr int RING_BYTES = 131072;
constexpr int P0SCR = 16896;
constexpr int MISC_OFF = 8 * P0SCR;
constexpr int TPRE_OFF = MISC_OFF + 128;
constexpr int RPRE_OFF = TPRE_OFF + 272;
constexpr int NCNT_OFF = RPRE_OFF + 272;
constexpr int TILEE_OFF = NCNT_OFF + 272;
constexpr int CPRE_OFF = TILEE_OFF + MAXTILES * 2;
constexpr int CHE_OFF = CPRE_OFF + 272;
constexpr int DCH = 2, MAXCH = 768;
constexpr int LDS_BYTES = 147456;
static_assert(CHE_OFF + MAXCH * 2 <= LDS_BYTES, "LDS map");

__device__ __forceinline__ unsigned f2bf(float f) { unsigned u = __builtin_bit_cast(unsigned, f); return (u + 0x7fffu + ((u >> 16) & 1u)) >> 16; }
__device__ __forceinline__ unsigned pk2(float lo, float hi) { return f2bf(lo) | (f2bf(hi) << 16); }
__device__ __forceinline__ float bf2f(unsigned short b) { return __builtin_bit_cast(float, (unsigned)b << 16); }
__device__ __forceinline__ float wave_sum(float v) {
#pragma unroll
    for (int o = 1; o < 64; o <<= 1) v += __shfl_xor(v, o);
    return v;
}
__device__ __forceinline__ int crow(int reg, int h) { return (reg & 3) + 8 * (reg >> 2) + 4 * h; }
#define XB_TMO      128
#define XB_XCNT(j)  (256  + 64 * (j))
#define XB_XSUB(j)  (1280 + 64 * (j))
#define XB_XGEN(j)  (2304 + 64 * (j))
#define XB_TOP      3328
#define XB_TOPGEN   3392
#define XCD_BAR_WORDS 3456
#define XB_SPIN_CAP (1u << 18)

__device__ __forceinline__ unsigned xb_ld(unsigned* p)              { return __hip_atomic_load(p, __ATOMIC_RELAXED, __HIP_MEMORY_SCOPE_AGENT); }
__device__ __forceinline__ unsigned xb_add(unsigned* p, unsigned v) { return __hip_atomic_fetch_add(p, v, __ATOMIC_RELAXED, __HIP_MEMORY_SCOPE_AGENT); }
__device__ __forceinline__ unsigned xb_xcc_id() { return (unsigned)__builtin_amdgcn_s_getreg((3 << 11) | 20) & 0xFu; }
#define XB_SPIN(cond, bar) do { unsigned _sp = 0; while (cond) { __builtin_amdgcn_s_sleep(1); \
    if ((++_sp & 255u) == 0u) { if (xb_ld(&(bar)[XB_TMO])) break; if (_sp > XB_SPIN_CAP) { atomicAdd(&(bar)[XB_TMO], 1u); break; } } } } while (0)

struct XcdBarrier {
    unsigned* bar; unsigned x;
    volatile LAS unsigned* st;
};

__device__ __forceinline__ XcdBarrier xcd_barrier_post(unsigned* bar, volatile LAS unsigned* st) {
    XcdBarrier b; b.bar = bar; b.x = xb_xcc_id(); b.st = st;
    if (threadIdx.x == 0) (void)xb_add(&bar[XB_XCNT(b.x)], 1u);
    return b;
}
__device__ __forceinline__ void xcd_barrier_complete(unsigned* bar, unsigned x, unsigned& nloc, unsigned& nx) {
    const unsigned G = gridDim.x * gridDim.y * gridDim.z;
    unsigned sum, cnt, mine, sp = 0u;
    for (;;) {
        sum = 0u; cnt = 0u; mine = 0u;
#pragma unroll
        for (unsigned j = 0; j < 16; ++j) { const unsigned c = xb_ld(&bar[XB_XCNT(j)]); sum += c; cnt += (c > 0u) ? 1u : 0u; mine = (j == x) ? c : mine; }
        if (sum == G) break;
        __builtin_amdgcn_s_sleep(1);
        if ((++sp & 255u) == 0u) { if (xb_ld(&bar[XB_TMO])) break; if (sp > XB_SPIN_CAP) { atomicAdd(&bar[XB_TMO], 1u); break; } }
    }
    nloc = mine > 0u ? mine : 1u; nx = cnt > 0u ? cnt : 1u;
}

__device__ __forceinline__ void xcd_barrier(const XcdBarrier& b) {
    asm volatile("s_waitcnt vmcnt(0)" ::: "memory");
    __syncthreads();
    if (threadIdx.x == 0) {
        unsigned* bar = b.bar;
        __builtin_amdgcn_s_waitcnt(0);
        unsigned nloc = b.st[0], nx = b.st[1];
        if (nloc == 0u) { xcd_barrier_complete(bar, b.x, nloc, nx); b.st[0] = nloc; b.st[1] = nx; }
        const unsigned old = xb_add(&bar[XB_XSUB(b.x)], 1u);
        const unsigned gen = old / nloc;
        if (old + 1u == (gen + 1u) * nloc) {
            __builtin_amdgcn_fence(__ATOMIC_RELEASE, "agent");
            asm volatile("s_waitcnt vmcnt(0)" ::: "memory");
            const unsigned og = xb_add(&bar[XB_TOP], 1u);
            const unsigned tg = og / nx;
            if (og + 1u == (tg + 1u) * nx) xb_add(&bar[XB_TOPGEN], 1u);
            else XB_SPIN(xb_ld(&bar[XB_TOPGEN]) == tg, bar);
            __builtin_amdgcn_fence(__ATOMIC_ACQUIRE, "agent");
            xb_add(&bar[XB_XGEN(b.x)], 1u);
            asm volatile("s_waitcnt vmcnt(0)" ::: "memory");
        } else {
            XB_SPIN(xb_ld(&bar[XB_XGEN(b.x)]) == gen, bar);
            __builtin_amdgcn_fence(__ATOMIC_ACQUIRE, "agent");
            asm volatile("s_waitcnt vmcnt(0)" ::: "memory");
        }
    }
    __syncthreads();
}
namespace pg8 {
#define PG8_LAS __attribute__((address_space(3)))
constexpr int BM = 256, BK = 64, HALF = 128, HTB = HALF * BK * 2  , STAGE_BYTES = 8 * HTB, NXCD = 8, WGM = 8;

__host__ __device__ __forceinline__ int lds_byte(int r, int c) { const int st = (r >> 4) * 2 + (c >> 5), rr = r & 15, cc = c & 31, ob = rr * 64 + cc * 2; return st * 1024 + (ob ^ (((ob >> 9) & 1) << 5)); }
__host__ __device__ __forceinline__ void stage_rc(int b, int& R, int& C) { const int st = b / 1024, sb = b % 1024, swz = sb ^ (((sb >> 9) & 1) << 5); R = (st >> 1) * 16 + swz / 64; C = (st & 1) * 32 + (swz % 64) / 2; }
__host__ __device__ __forceinline__ int perm32(int rho) { const int n = rho >> 4, i = rho & 15; return 8 * (i >> 2) + 4 * n + (i & 3); }

struct Unit { const char* aB; const char* bB; int pm, pn, e, row0, nvalid; };

typedef int i32x8 __attribute__((ext_vector_type(8))); typedef int i32x4v __attribute__((ext_vector_type(4)));
__device__ __forceinline__ bf16x8 lo8(i32x8 a) { return __builtin_bit_cast(bf16x8, (i32x4v)__builtin_shufflevector(a, a, 0, 1, 2, 3)); }
__device__ __forceinline__ bf16x8 hi8(i32x8 a) { return __builtin_bit_cast(bf16x8, (i32x4v)__builtin_shufflevector(a, a, 4, 5, 6, 7)); }
__device__ __forceinline__ unsigned cvt_pk_bf16(float lo, float hi) { unsigned r; asm volatile("v_cvt_pk_bf16_f32 %0, %1, %2" : "=v"(r) : "v"(lo), "v"(hi)); return r; }

__device__ __forceinline__ int xcd_remap(int L, int nwg) { const int q = nwg / NXCD, r = nwg % NXCD, xcd = L % NXCD, off = L / NXCD; return (xcd < r ? xcd * (q + 1) : r * (q + 1) + (xcd - r) * q) + off; }

struct DenseOrder {
    const char* A; const char* Bt; int nM, nN, nwg, G, c, K;
    __device__ void init(const bf16_t* A_, const bf16_t* Bt_, int M_, int N_, int K_, int G_, int c_) { A = (const char*)A_; Bt = (const char*)Bt_; nM = M_ / BM; nN = N_ / BM; nwg = nM * nN; G = G_; c = c_; K = K_; }
    __device__ __forceinline__ bool next(int i, Unit& u) const {
        const long L = (long)i * G + c; if (L >= nwg) return false;
        const int wgid = xcd_remap((int)L, nwg);
        const int nig = WGM * nN, gid = wgid / nig, fm = gid * WGM, gsz = (nM - fm) < WGM ? (nM - fm) : WGM;
        u.pm = fm + ((wgid % nig) % gsz); u.pn = (wgid % nig) / gsz; u.e = 0; u.row0 = u.pm * BM; u.nvalid = BM;
        u.aB = A + (size_t)u.pm * BM * K * 2; u.bB = Bt + (size_t)u.pn * BM * K * 2; return true;
    }
    __device__ __forceinline__ void a_voff(const Unit&, const int (&R)[2], const int (&C)[2], unsigned (&vo)[2][2]) const {
#pragma unroll
        for (int h = 0; h < 2; ++h)
#pragma unroll
            for (int i = 0; i < 2; ++i) vo[h][i] = (unsigned)((R[i] + HALF * h) * K + C[i]) * 2u;
    }
};

template <class Epi, class Sched, bool ALIGN_EPI, bool FP8 = false>
__device__ __forceinline__ void gemm_phase(PG8_LAS unsigned char* lds, const int K, const Sched& S, const Epi& E) {
    const int tid = threadIdx.x, wid = __builtin_amdgcn_readfirstlane(tid >> 6), lane = tid & 63, wr = wid >> 2, wc = wid & 3, fr = lane & 15, fq = lane >> 4;
    constexpr int EB = FP8 ? 1 : 2;
    const int nt = K * EB / 128;
    int RA[2], CA[2]; unsigned voffB[2][2];
#pragma unroll
    for (int i = 0; i < 2; ++i) { int R, C; stage_rc(tid * 16 + i * 8192, R, C); RA[i] = R; CA[i] = C;
#pragma unroll
        for (int h = 0; h < 2; ++h) { int Rb;
            if (Epi::PERM == 2) Rb = 64 * (R >> 5) + 16 * ((R >> 2) & 3) + 8 * h + 4 * ((R >> 4) & 1) + (R & 3);
            else Rb = HALF * h + (Epi::PERM == 1 ? ((R & ~31) + perm32(R & 31)) : R);
            voffB[h][i] = (unsigned)(Rb * K * EB + C * 2); asm volatile("" : "+v"(voffB[h][i])); } }
    const size_t kstep = (size_t)(BK * 2);
    const unsigned ldsw = (unsigned)wid * 1024u;
    const int aoff = lds_byte(wr * 64 + fr, fq * 8), boff = lds_byte(wc * 32 + fr, fq * 8);
#define PG8_SA(b, h) (((b) * 2 + (h)) * HTB)
#define PG8_SB(b, h) ((4 + (b) * 2 + (h)) * HTB)
#define PG8_STAGE(bufoff, gbase, voff) do { _Pragma("unroll") for (int _i = 0; _i < 2; ++_i) \
        __builtin_amdgcn_global_load_lds((const unsigned*)((const char*)(gbase) + (voff)[_i]), (PG8_LAS unsigned*)(lds + (bufoff) + ldsw + _i * 8192), 16, 0, 0); } while (0)
#define PG8_LD8(addr) __builtin_shufflevector(*(const PG8_LAS i32x4v*)(addr), *(const PG8_LAS i32x4v*)((addr) + 1024), 0, 1, 2, 3, 4, 5, 6, 7)
#define PG8_LDA(dst, b, h) do { _Pragma("unroll") for (int m = 0; m < 4; ++m) dst[m] = PG8_LD8(lds + PG8_SA(b, h) + aoff + m * 2048); } while (0)
#define PG8_LDB(dst, b, h) do { _Pragma("unroll") for (int n = 0; n < 2; ++n) dst[n] = PG8_LD8(lds + PG8_SB(b, h) + boff + n * 2048); } while (0)
#define PG8_MMA(ai, bj, At, Bt) do { __builtin_amdgcn_s_setprio(1); _Pragma("unroll") for (int m = 0; m < 4; ++m) _Pragma("unroll") for (int n = 0; n < 2; ++n) { \
        if constexpr (FP8) asm volatile("v_mfma_scale_f32_16x16x128_f8f6f4 %0, %1, %2, %0, %3, %3 op_sel_hi:[0,0,0]" : "+v"(acc[ai][bj][m][n]) : "v"(Bt[n]), "v"(At[m]), "v"(sc7f));   \
        else { acc[ai][bj][m][n] = __builtin_amdgcn_mfma_f32_16x16x32_bf16(lo8(Bt[n]), lo8(At[m]), acc[ai][bj][m][n], 0, 0, 0); \
               acc[ai][bj][m][n] = __builtin_amdgcn_mfma_f32_16x16x32_bf16(hi8(Bt[n]), hi8(At[m]), acc[ai][bj][m][n], 0, 0, 0); } } \
        __builtin_amdgcn_s_setprio(0); } while (0)
#define PG8_WAIT_V(n) asm volatile("s_waitcnt vmcnt(" #n ")" ::: "memory")
#define PG8_WAIT_L(n) asm volatile("s_waitcnt lgkmcnt(" #n ")" ::: "memory")
#define PG8_BAR __builtin_amdgcn_s_barrier()
#define PG8_SCHED __builtin_amdgcn_sched_barrier(0)
    const int sc7f = 0x7F7F7F7F;
    Unit cur, nxt; int ui = 0;
    if (!S.next(0, cur)) return;
    unsigned vA[2][2], vN[2][2];
    S.a_voff(cur, RA, CA, vA);
#define PG8_OPQ(v) do { _Pragma("unroll") for (int h_ = 0; h_ < 2; ++h_) _Pragma("unroll") for (int i_ = 0; i_ < 2; ++i_) asm volatile("" : "+v"(v[h_][i_])); } while (0)
    PG8_OPQ(vA);
    f32x4 acc[2][2][4][2];
#pragma unroll
    for (int a = 0; a < 2; ++a)
#pragma unroll
        for (int b = 0; b < 2; ++b)
#pragma unroll
            for (int m = 0; m < 4; ++m)
#pragma unroll
                for (int n = 0; n < 2; ++n) acc[a][b][m][n] = (f32x4){0.f, 0.f, 0.f, 0.f};
    i32x8 At[4], B0[2], B1[2];
    const char* cA = cur.aB; const char* cB = cur.bB;
    PG8_STAGE(PG8_SB(0, 0), cB, voffB[0]); PG8_STAGE(PG8_SB(0, 1), cB, voffB[1]); PG8_STAGE(PG8_SA(0, 0), cA, vA[0]); PG8_STAGE(PG8_SA(0, 1), cA, vA[1]);
    if (wr == 1) PG8_BAR;
    PG8_WAIT_V(2); PG8_BAR;
    PG8_STAGE(PG8_SB(1, 0), cB + kstep, voffB[0]); PG8_STAGE(PG8_SA(1, 0), cA + kstep, vA[0]); PG8_STAGE(PG8_SB(1, 1), cB + kstep, voffB[1]);
    PG8_WAIT_V(6); PG8_BAR;
    for (;;) {
        const bool has_next = S.next(ui + 1, nxt);
        const char* nA = has_next ? nxt.aB : cA; const char* nB = has_next ? nxt.bB : cB;
        if (has_next) { S.a_voff(nxt, RA, CA, vN); PG8_OPQ(vN); }
        else {
#pragma unroll
            for (int h = 0; h < 2; ++h)
#pragma unroll
                for (int i = 0; i < 2; ++i) vN[h][i] = vA[h][i]; }
#pragma unroll 1
        for (int t = 0; t < nt; t += 2) {
            const bool last = (t == nt - 2);
            const char* a1 = cA + (size_t)(t + 1) * kstep;
            const char* a2 = last ? nA : cA + (size_t)(t + 2) * kstep; const char* b2 = last ? nB : cB + (size_t)(t + 2) * kstep;
            const char* a3 = a2 + kstep; const char* b3 = b2 + kstep;
            unsigned w2[2][2];
#pragma unroll
            for (int h = 0; h < 2; ++h)
#pragma unroll
                for (int i = 0; i < 2; ++i) w2[h][i] = last ? vN[h][i] : vA[h][i];
            PG8_LDB(B0, 0, 0); PG8_LDB(B1, 0, 1); PG8_SCHED; PG8_LDA(At, 0, 0); PG8_STAGE(PG8_SA(1, 1), a1, vA[1]);
            PG8_WAIT_V(8); PG8_WAIT_L(0); PG8_BAR; PG8_MMA(0, 0, At, B0); PG8_MMA(0, 1, At, B1); PG8_BAR; PG8_SCHED;
            PG8_LDA(At, 0, 1); PG8_STAGE(PG8_SB(0, 0), b2, voffB[0]); PG8_STAGE(PG8_SB(0, 1), b2, voffB[1]); PG8_STAGE(PG8_SA(0, 0), a2, w2[0]);
            PG8_WAIT_V(8); PG8_WAIT_L(0); PG8_BAR; PG8_MMA(1, 0, At, B0); PG8_MMA(1, 1, At, B1); PG8_BAR; PG8_SCHED;
            PG8_LDB(B0, 1, 0); PG8_LDB(B1, 1, 1); PG8_SCHED; PG8_LDA(At, 1, 0); PG8_STAGE(PG8_SA(0, 1), a2, w2[1]);
            PG8_WAIT_V(8); PG8_WAIT_L(0); PG8_BAR; PG8_MMA(0, 0, At, B0); PG8_MMA(0, 1, At, B1); PG8_BAR; PG8_SCHED;
            PG8_LDA(At, 1, 1); PG8_STAGE(PG8_SB(1, 0), b3, voffB[0]); PG8_STAGE(PG8_SB(1, 1), b3, voffB[1]); PG8_STAGE(PG8_SA(1, 0), a3, w2[0]);
            PG8_WAIT_V(8); PG8_WAIT_L(0); PG8_BAR; PG8_MMA(1, 0, At, B0); PG8_MMA(1, 1, At, B1); PG8_BAR; PG8_SCHED;
        }
        if constexpr (ALIGN_EPI) { if (wr == 0) PG8_BAR; }
        if constexpr (FP8) asm volatile("s_nop 15\n\ts_nop 15" ::: "memory");
        E(acc, cur, wr, wc, fr, fq);
        if (!has_next) break;
#pragma unroll
        for (int a = 0; a < 2; ++a)
#pragma unroll
            for (int b = 0; b < 2; ++b)
#pragma unroll
                for (int m = 0; m < 4; ++m)
#pragma unroll
                    for (int n = 0; n < 2; ++n) acc[a][b][m][n] = (f32x4){0.f, 0.f, 0.f, 0.f};
        cur = nxt; cA = nA; cB = nB; ++ui;
#pragma unroll
        for (int h = 0; h < 2; ++h)
#pragma unroll
            for (int i = 0; i < 2; ++i) vA[h][i] = vN[h][i];
        if constexpr (ALIGN_EPI) { if (wr == 1) PG8_BAR; }
    }
    PG8_WAIT_V(0);
    if constexpr (!ALIGN_EPI) { if (wr == 0) PG8_BAR; }
    PG8_BAR;
#undef PG8_OPQ
#undef PG8_SA
#undef PG8_SB
#undef PG8_STAGE
#undef PG8_LDA
#undef PG8_LDB
#undef PG8_MMA
#undef PG8_WAIT_V
#undef PG8_WAIT_L
#undef PG8_BAR
#undef PG8_SCHED
}

struct EpiBf16 {
    static constexpr int PERM = 1;
    bf16_t* O; int ldc;
    __device__ __forceinline__ void operator()(const f32x4 (&acc)[2][2][4][2], const Unit& u, int wr, int wc, int fr, int fq) const {
        const int row0 = u.row0 + wr * 64 + fr, col0 = u.pn * BM + wc * 32 + 8 * fq;
#pragma unroll
        for (int ai = 0; ai < 2; ++ai)
#pragma unroll
            for (int m = 0; m < 4; ++m) { bf16_t* rowp = O + (size_t)(row0 + ai * HALF + m * 16) * ldc + col0;
#pragma unroll
                for (int bj = 0; bj < 2; ++bj) { const f32x4 v0 = acc[ai][bj][m][0], v1 = acc[ai][bj][m][1];
                    u32x4 w; w.x = cvt_pk_bf16(v0[0], v0[1]); w.y = cvt_pk_bf16(v0[2], v0[3]); w.z = cvt_pk_bf16(v1[0], v1[1]); w.w = cvt_pk_bf16(v1[2], v1[3]);
                    *(u32x4*)(rowp + bj * HALF) = w; } }
    }
};
__device__ __forceinline__ float clamp_fp8(float v) { return __builtin_amdgcn_fmed3f(v, -416.0f, 416.0f); }
__device__ __forceinline__ unsigned pack_fp8x4(const f32x4 v) { int w = 0; w = __builtin_amdgcn_cvt_pk_fp8_f32(clamp_fp8(v[0]), clamp_fp8(v[1]), w, false); w = __builtin_amdgcn_cvt_pk_fp8_f32(clamp_fp8(v[2]), clamp_fp8(v[3]), w, true); return (unsigned)w; }
struct EpiResF32 {
    static constexpr int PERM = 2;
    const float* base; float* out; unsigned char* x8; int ldc;
    __device__ __forceinline__ void operator()(const f32x4 (&acc)[2][2][4][2], const Unit& u, int wr, int wc, int fr, int fq) const {
        const int row0 = u.row0 + wr * 64 + fr, col0 = u.pn * BM + wc * 64 + 16 * fq;
#pragma unroll
        for (int ai = 0; ai < 2; ++ai)
#pragma unroll
            for (int m = 0; m < 4; ++m) { const size_t off = (size_t)(row0 + ai * HALF + m * 16) * ldc + col0; u32x4 w;
#pragma unroll
                for (int bj = 0; bj < 2; ++bj)
#pragma unroll
                    for (int n = 0; n < 2; ++n) { const f32x4 o = *(const f32x4*)(base + off + 8 * bj + 4 * n) + acc[ai][bj][m][n]; *(f32x4*)(out + off + 8 * bj + 4 * n) = o; w[2 * bj + n] = pack_fp8x4(o); }
                *(u32x4*)(x8 + off) = w; }
    }
};
__device__ __forceinline__ float silu_mul(float g, float u) { return g * __builtin_amdgcn_rcpf(1.0f + __expf(-g)) * u; }
struct EpiSwiglu {
    static constexpr int PERM = 1;
    unsigned char* H; const float* rl; const float* rstd2;
    __device__ __forceinline__ void operator()(const f32x4 (&acc)[2][2][4][2], const Unit& u, int wr, int wc, int fr, int fq) const {
        const int rt0 = wr * 64 + fr, col0 = u.pn * HALF + wc * 32 + 8 * fq;
        const float* srow = (u.e < NE ? rl + (size_t)u.e * LISTCAP : rstd2) + u.pm * BM;
        float sv[2][4];
#pragma unroll
        for (int ai = 0; ai < 2; ++ai)
#pragma unroll
            for (int m = 0; m < 4; ++m) { const int rt = rt0 + ai * HALF + m * 16; sv[ai][m] = srow[rt < u.nvalid ? rt : 0]; }
        asm volatile("" : "+v"(sv[0][0]), "+v"(sv[0][1]), "+v"(sv[0][2]), "+v"(sv[0][3]), "+v"(sv[1][0]), "+v"(sv[1][1]), "+v"(sv[1][2]), "+v"(sv[1][3]));
#pragma unroll
        for (int ai = 0; ai < 2; ++ai)
#pragma unroll
            for (int m = 0; m < 4; ++m) { const int rt = rt0 + ai * HALF + m * 16;
                if (rt < u.nvalid) { const float s = sv[ai][m] * (1.0f / GU_SCALE); const f32x4 g0 = acc[ai][0][m][0] * s, g1 = acc[ai][0][m][1] * s, u0 = acc[ai][1][m][0] * s, u1 = acc[ai][1][m][1] * s;
                    const f32x4 h0 = {silu_mul(g0[0], u0[0]), silu_mul(g0[1], u0[1]), silu_mul(g0[2], u0[2]), silu_mul(g0[3], u0[3])}, h1 = {silu_mul(g1[0], u1[0]), silu_mul(g1[1], u1[1]), silu_mul(g1[2], u1[2]), silu_mul(g1[3], u1[3])};
                    *(unsigned long long*)(H + (size_t)(u.row0 + rt) * DE + col0) = (unsigned long long)pack_fp8x4(h0) | ((unsigned long long)pack_fp8x4(h1) << 32); } }
    }
};
struct EpiDown {
    static constexpr int PERM = 2;
    unsigned char* Y; const float* wl;
    __device__ __forceinline__ void operator()(const f32x4 (&acc)[2][2][4][2], const Unit& u, int wr, int wc, int fr, int fq) const {
        const int rt0 = wr * 64 + fr, col0 = u.pn * BM + wc * 64 + 16 * fq;
        const float* wrow = wl + (size_t)(u.e < NE ? u.e : 0) * LISTCAP + u.pm * BM;
        float wv[2][4];
#pragma unroll
        for (int ai = 0; ai < 2; ++ai)
#pragma unroll
            for (int m = 0; m < 4; ++m) { const int rt = rt0 + ai * HALF + m * 16; wv[ai][m] = wrow[rt < u.nvalid ? rt : 0]; }
#pragma unroll
        for (int ai = 0; ai < 2; ++ai)
#pragma unroll
            for (int m = 0; m < 4; ++m) { const int rt = rt0 + ai * HALF + m * 16;
                if (rt < u.nvalid) { const float w = ((u.e < NE) ? wv[ai][m] : 1.0f) * (YSCALE / DN_SCALE);
                    u32x4 p; p.x = pack_fp8x4(acc[ai][0][m][0] * w); p.y = pack_fp8x4(acc[ai][0][m][1] * w); p.z = pack_fp8x4(acc[ai][1][m][0] * w); p.w = pack_fp8x4(acc[ai][1][m][1] * w);
                    *(u32x4*)(Y + (size_t)(u.row0 + rt) * D + col0) = p; } }
    }
};

template <bool GATHER> struct GroupedOrder {
    const PG8_LAS int* tpre; const PG8_LAS int* rpre; const PG8_LAS int* ncnt; const PG8_LAS unsigned short* tile_e;
    const char* A; const char* Bt; const int* tok; size_t b_estride; int npn, pn0, nU, G, c, K;
    __device__ __forceinline__ bool next(int i, Unit& u) const {
        const long L = (long)i * G + c; if (L >= nU) return false;
        const int wgid = xcd_remap((int)L, nU), tile = wgid / npn, pnl = wgid % npn;
        const int e = __builtin_amdgcn_readfirstlane((int)tile_e[tile]);
        const int mt = tile - __builtin_amdgcn_readfirstlane(tpre[e]), r0 = __builtin_amdgcn_readfirstlane(rpre[e]) + mt * BM, ne = __builtin_amdgcn_readfirstlane(ncnt[e]);
        u.e = e; u.pm = mt; u.pn = pn0 + pnl; u.row0 = r0; u.nvalid = (ne - mt * BM) < BM ? (ne - mt * BM) : BM;
        u.aB = GATHER ? A : A + (size_t)r0 * K; u.bB = Bt + (size_t)e * b_estride + (size_t)u.pn * BM * K; return true;
    }
    __device__ __forceinline__ void a_voff(const Unit& u, const int (&R)[2], const int (&C)[2], unsigned (&vo)[2][2]) const {
#pragma unroll
        for (int h = 0; h < 2; ++h)
#pragma unroll
            for (int i = 0; i < 2; ++i) { const int rt = R[i] + HALF * h;
                if (GATHER) { int t = 0; if (rt < u.nvalid) t = (u.e < NE) ? tok[(size_t)u.e * LISTCAP + u.pm * BM + rt] : (u.pm * BM + rt);
                    vo[h][i] = (unsigned)(t * K + C[i] * 2); }
                else vo[h][i] = (unsigned)(rt * K + C[i] * 2); }
    }
};

struct Down {
    const PG8_LAS int* tpre; const PG8_LAS int* rpre; const PG8_LAS int* ncnt; const PG8_LAS int* cpre; const PG8_LAS unsigned short* chunk_e;
    const unsigned char* Hb; const unsigned char* Wd; const float* wl; unsigned char* Y; int nU, G, c;
};
__device__ __forceinline__ void down_phase(PG8_LAS unsigned char* lds, const Down& P) {
    constexpr int K = DE;
    const int tid = threadIdx.x, wid = __builtin_amdgcn_readfirstlane(tid >> 6), lane = tid & 63, wr = wid >> 2, wc = wid & 3, fr = lane & 15, fq = lane >> 4;
    int RA[2], CA[2];
#pragma unroll
    for (int i = 0; i < 2; ++i) { int R, C; stage_rc(tid * 16 + i * 8192, R, C); RA[i] = R; CA[i] = C; }
    const unsigned ldsw = (unsigned)wid * 1024u;
    const int aoff = lds_byte(fr, fq * 8);
    const int sc7f = 0x7F7F7F7F;
#define DN_A(slot, kt, rh) ((slot) * 65536 + ((kt) * 2 + (rh)) * HTB)
#define DN_STAGE_A(slot, abase) do { _Pragma("unroll") for (int kt_ = 0; kt_ < 2; ++kt_) _Pragma("unroll") for (int rh_ = 0; rh_ < 2; ++rh_) _Pragma("unroll") for (int _i = 0; _i < 2; ++_i) \
        __builtin_amdgcn_global_load_lds((const unsigned*)((abase) + (size_t)((rh_ * HALF + RA[_i]) * K + kt_ * 128 + CA[_i] * 2)), (PG8_LAS unsigned*)(lds + DN_A(slot, kt_, rh_) + ldsw + _i * 8192), 16, 0, 0); } while (0)
#define DN_DECODE(Lv, e_, mt_, nt_, cq_) do { const int wg_ = xcd_remap((int)(Lv), P.nU), chk_ = wg_ >> 2; cq_ = wg_ & 3; e_ = __builtin_amdgcn_readfirstlane((int)P.chunk_e[chk_]); \
        mt_ = (chk_ - __builtin_amdgcn_readfirstlane(P.cpre[e_])) * DCH; const int tl_ = (__builtin_amdgcn_readfirstlane(P.ncnt[e_]) + BM - 1) / BM - mt_; nt_ = tl_ < DCH ? tl_ : DCH; } while (0)
#define DN_LOADB(BF, e_, cq_) do { const unsigned char* wb_ = P.Wd + ((size_t)(e_) * D + (cq_) * 256 + wc * 64 + 16 * (fr >> 2) + (fr & 3)) * K + 16 * fq; \
        _Pragma("unroll") for (int n_ = 0; n_ < 4; ++n_) _Pragma("unroll") for (int kt_ = 0; kt_ < 2; ++kt_) { const unsigned char* q_ = wb_ + (size_t)(4 * n_) * K + kt_ * 128; \
            BF[n_][kt_] = __builtin_shufflevector(*(const i32x4v*)q_, *(const i32x4v*)(q_ + 64), 0, 1, 2, 3, 4, 5, 6, 7); } } while (0)
    long L = P.c; if (L >= P.nU) return;
    int e, mt, ntl, cq; DN_DECODE(L, e, mt, ntl, cq);
    i32x8 Bf[4][2], Bn[4][2];
    DN_LOADB(Bf, e, cq);
    int r0 = __builtin_amdgcn_readfirstlane(P.rpre[e]) + mt * BM, nrem = __builtin_amdgcn_readfirstlane(P.ncnt[e]) - mt * BM;
    const float* wrow = P.wl + (size_t)(e < NE ? e : 0) * LISTCAP + mt * BM;
    DN_STAGE_A(0, P.Hb + (size_t)r0 * K);
    float wv[8], wn[8];
#pragma unroll
    for (int m = 0; m < 8; ++m) { const int rt = wr * HALF + m * 16 + fr; wv[m] = wrow[rt < nrem ? rt : 0]; }
    asm volatile("" : "+v"(wv[0]), "+v"(wv[1]), "+v"(wv[2]), "+v"(wv[3]), "+v"(wv[4]), "+v"(wv[5]), "+v"(wv[6]), "+v"(wv[7]));
#pragma unroll
    for (int m = 0; m < 8; ++m) wv[m] = ((e < NE) ? wv[m] : 1.0f) * (YSCALE / DN_SCALE);
    int slot = 0, ti = 0;
    for (;;) {
        __syncthreads();
        const bool last_tile = (ti + 1 == ntl); const long Ln = L + P.G; const bool has_next_unit = Ln < P.nU;
        int e2 = e, mt2 = mt, ntl2 = ntl, cq2 = cq; int r0n = r0 + BM, nremn = nrem - BM; const float* wrown = wrow + BM; bool have = true;
        if (last_tile) { if (has_next_unit) { DN_DECODE(Ln, e2, mt2, ntl2, cq2); r0n = __builtin_amdgcn_readfirstlane(P.rpre[e2]) + mt2 * BM; nremn = __builtin_amdgcn_readfirstlane(P.ncnt[e2]) - mt2 * BM;
                wrown = P.wl + (size_t)(e2 < NE ? e2 : 0) * LISTCAP + mt2 * BM; } else have = false; }
        if (have) { DN_STAGE_A(slot ^ 1, P.Hb + (size_t)r0n * K);
#pragma unroll
            for (int m = 0; m < 8; ++m) { const int rt = wr * HALF + m * 16 + fr; wn[m] = wrown[rt < nremn ? rt : 0]; }
            if (last_tile) DN_LOADB(Bn, e2, cq2); }
        const int col0 = cq * 256 + wc * 64 + 16 * fq;
#pragma unroll
        for (int m = 0; m < 8; ++m) {
            i32x8 Af[2];
#pragma unroll
            for (int kt = 0; kt < 2; ++kt) { const PG8_LAS unsigned char* a = lds + DN_A(slot, kt, wr) + aoff + m * 2048; Af[kt] = __builtin_shufflevector(*(const PG8_LAS i32x4v*)a, *(const PG8_LAS i32x4v*)(a + 1024), 0, 1, 2, 3, 4, 5, 6, 7); }
            f32x4 acc[4];
#pragma unroll
            for (int n = 0; n < 4; ++n) acc[n] = (f32x4){0.f, 0.f, 0.f, 0.f};
#pragma unroll
            for (int kt = 0; kt < 2; ++kt)
#pragma unroll
                for (int n = 0; n < 4; ++n) asm volatile("v_mfma_scale_f32_16x16x128_f8f6f4 %0, %1, %2, %0, %3, %3 op_sel_hi:[0,0,0]" : "+v"(acc[n]) : "v"(Bf[n][kt]), "v"(Af[kt]), "v"(sc7f));
            asm volatile("s_nop 15\n\ts_nop 3" : "+v"(acc[0]), "+v"(acc[1]), "+v"(acc[2]), "+v"(acc[3]));
            const int rt = wr * HALF + m * 16 + fr;
            if (rt < nrem) { u32x4 p; p.x = pack_fp8x4(acc[0] * wv[m]); p.y = pack_fp8x4(acc[1] * wv[m]); p.z = pack_fp8x4(acc[2] * wv[m]); p.w = pack_fp8x4(acc[3] * wv[m]);
                *(u32x4*)(P.Y + (size_t)(r0 + rt) * D + col0) = p; }
        }
        if (!have) break;
#pragma unroll
        for (int m = 0; m < 8; ++m) wv[m] = wn[m];
        asm volatile("" : "+v"(wv[0]), "+v"(wv[1]), "+v"(wv[2]), "+v"(wv[3]), "+v"(wv[4]), "+v"(wv[5]), "+v"(wv[6]), "+v"(wv[7]));
#pragma unroll
        for (int m = 0; m < 8; ++m) wv[m] = ((e2 < NE) ? wv[m] : 1.0f) * (YSCALE / DN_SCALE);
        r0 = r0n; nrem = nremn; wrow = wrown; slot ^= 1;
        if (last_tile) { L = Ln; e = e2; mt = mt2; ntl = ntl2; cq = cq2; ti = 0;
#pragma unroll
            for (int n = 0; n < 4; ++n) { Bf[n][0] = Bn[n][0]; Bf[n][1] = Bn[n][1]; } }
        else ++ti;
    }
    __syncthreads();
#undef DN_A
#undef DN_STAGE_A
#undef DN_DECODE
#undef DN_LOADB
}
}

constexpr int NWAVES = 8;
struct Args { const float* in[19]; float* out; unsigned char* ws; int ph_lo, ph_hi; };

template <bool SCALE>
__device__ __forceinline__ void p0_transpose_item(const float* W, int K, int N, bf16_t* WT, int mode, const float* ksc, LAS float* scr, int item, int lane) {
    const int nblk = N / 64, kb = item / nblk, nb = item % nblk, k0 = 64 * kb, n0 = 64 * nb;
    const int rowbase = (mode == 0) ? n0 : ((n0 >> 7) * 256 + (n0 & 127) + (mode == 2 ? 128 : 0));
    const int r4 = lane >> 4, c16 = lane & 15;
    f32x4 v[16];
#pragma unroll
    for (int i = 0; i < 16; ++i) v[i] = *(const f32x4*)(W + (size_t)(k0 + 4 * i + r4) * N + n0 + 4 * c16);
    const int c = lane & 7, nrow = lane >> 3;
    f32x4 s0 = (f32x4){1.f, 1.f, 1.f, 1.f}, s1 = s0;
    if (SCALE) { s0 = *(const f32x4*)(ksc + k0 + 8 * c); s1 = *(const f32x4*)(ksc + k0 + 8 * c + 4); }
#pragma unroll
    for (int i = 0; i < 16; ++i) { LAS float* d = scr + (4 * i + r4) * 65 + 4 * c16; d[0] = v[i].x; d[1] = v[i].y; d[2] = v[i].z; d[3] = v[i].w; }
    LDS_WAIT(); asm volatile("" ::: "memory");
#pragma unroll
    for (int j = 0; j < 8; ++j) { const int n = nrow + 8 * j; const LAS float* s = scr + (8 * c) * 65 + n;
        v4u o; o.x = pk2(s[0 * 65] * s0.x, s[1 * 65] * s0.y); o.y = pk2(s[2 * 65] * s0.z, s[3 * 65] * s0.w); o.z = pk2(s[4 * 65] * s1.x, s[5 * 65] * s1.y); o.w = pk2(s[6 * 65] * s1.z, s[7 * 65] * s1.w);
        *(GAS v4u*)(WT + (size_t)(rowbase + n) * K + k0 + 8 * c) = o; }
    LDS_WAIT(); asm volatile("" ::: "memory");
}
template <bool SCALE>
__device__ __forceinline__ void p0_transpose_item8(const float* W, int K, int N, unsigned char* WT, int mode, const float* ksc, float scale, LAS float* scr, int item, int lane) {
    const int nblk = N / 32, kb = item / nblk, nb = item % nblk, k0 = 128 * kb, n0 = 32 * nb;
    const int rowbase = (mode == 0) ? n0 : ((n0 >> 7) * 256 + (n0 & 127) + (mode == 2 ? 128 : 0));
    const int r8 = lane >> 3, c8 = lane & 7;
    f32x4 v[16];
#pragma unroll
    for (int i = 0; i < 16; ++i) v[i] = *(const f32x4*)(W + (size_t)(k0 + 8 * i + r8) * N + n0 + 4 * c8);
#pragma unroll
    for (int i = 0; i < 16; ++i) { LAS float* d = scr + (8 * i + r8) * 33 + 4 * c8; d[0] = v[i].x; d[1] = v[i].y; d[2] = v[i].z; d[3] = v[i].w; }
    LDS_WAIT(); asm volatile("" ::: "memory");
    const int c = lane & 7, nrow = lane >> 3;
    f32x4 sc4[4];
#pragma unroll
    for (int q = 0; q < 4; ++q) { sc4[q] = (f32x4){scale, scale, scale, scale}; if (SCALE) sc4[q] = *(const f32x4*)(ksc + k0 + 16 * c + 4 * q) * scale; }
#pragma unroll
    for (int j = 0; j < 4; ++j) { const int n = nrow + 8 * j; const LAS float* s = scr + (16 * c) * 33 + n; u32x4 o;
#pragma unroll
        for (int q = 0; q < 4; ++q) { const f32x4 t = {s[(4 * q) * 33] * sc4[q].x, s[(4 * q + 1) * 33] * sc4[q].y, s[(4 * q + 2) * 33] * sc4[q].z, s[(4 * q + 3) * 33] * sc4[q].w}; o[q] = pg8::pack_fp8x4(t); }
        *(GAS u32x4*)(WT + (size_t)(rowbase + n) * K + k0 + 16 * c) = o; }
    LDS_WAIT(); asm volatile("" ::: "memory");
}
__device__ __forceinline__ void rms_rows2_to_bf16(const float* xa, const float* xb_, const float* w, bf16_t* oa, bf16_t* ob, int lane) {
    const f32x4* xr0 = (const f32x4*)xa + lane; const f32x4* xr1 = (const f32x4*)xb_ + lane; const f32x4* wr = (const f32x4*)w + lane;
    f32x4 v0[4], v1[4]; float s0 = 0.f, s1 = 0.f;
#pragma unroll
    for (int j = 0; j < 4; ++j) { v0[j] = xr0[64 * j]; v1[j] = xr1[64 * j]; }
#pragma unroll
    for (int j = 0; j < 4; ++j) { s0 += (v0[j].x * v0[j].x + v0[j].y * v0[j].y) + (v0[j].z * v0[j].z + v0[j].w * v0[j].w); s1 += (v1[j].x * v1[j].x + v1[j].y * v1[j].y) + (v1[j].z * v1[j].z + v1[j].w * v1[j].w); }
    const float r0 = 1.0f / sqrtf(wave_sum(s0) * (1.0f / D) + EPS), r1 = 1.0f / sqrtf(wave_sum(s1) * (1.0f / D) + EPS);
    unsigned long long* o0 = (unsigned long long*)oa + lane; unsigned long long* o1 = (unsigned long long*)ob + lane;
#pragma unroll
    for (int j = 0; j < 4; ++j) { const f32x4 ww = wr[64 * j];
        o0[64 * j] = (unsigned long long)pk2(v0[j].x * r0 * ww.x, v0[j].y * r0 * ww.y) | ((unsigned long long)pk2(v0[j].z * r0 * ww.z, v0[j].w * r0 * ww.w) << 32);
        o1[64 * j] = (unsigned long long)pk2(v1[j].x * r1 * ww.x, v1[j].y * r1 * ww.y) | ((unsigned long long)pk2(v1[j].z * r1 * ww.z, v1[j].w * r1 * ww.w) << 32); }
}

__device__ __forceinline__ void conv_token(const bf16_t* P, const float* conv_w, const float* nw, bf16_t* ymix, int t, int lane) {
    const int s = t % SEQ, c0 = lane * 8;
    float v[8];
#pragma unroll
    for (int j = 0; j < 8; ++j) v[j] = 0.f;
#pragma unroll
    for (int k = 0; k < 3; ++k) { const int ds = k - 2;
        if (s + ds >= 0) { const bf16_t* row = P + (size_t)(t + ds) * NPROJ; const bf16x8 cg = *(const bf16x8*)(row + OFF_C + c0), hh = *(const bf16x8*)(row + OFF_H + c0);
#pragma unroll
            for (int j = 0; j < 8; ++j) v[j] += conv_w[k * DCONV + c0 + j] * (bf2f((unsigned short)cg[j]) * bf2f((unsigned short)hh[j])); } }
    const bf16x8 bg = *(const bf16x8*)(P + (size_t)t * NPROJ + OFF_B + c0); float ss = 0.f;
#pragma unroll
    for (int j = 0; j < 8; ++j) { v[j] *= bf2f((unsigned short)bg[j]); ss += v[j] * v[j]; }
    const float rstd = 1.0f / sqrtf(wave_sum(ss) * (1.0f / DCONV) + EPS);
    bf16x8 o;
#pragma unroll
    for (int j = 0; j < 8; ++j) o[j] = (short)f2bf(v[j] * rstd * nw[c0 + j]);
    *(bf16x8*)(ymix + (size_t)t * D + c0) = o;
}
constexpr int ATT_VB = 20480;
constexpr int ATT_SSQ = 2 * ATT_VB;
typedef short v4i16_t __attribute__((ext_vector_type(4)));
typedef float f32x2_t __attribute__((ext_vector_type(2))); typedef __bf16 bf16x2_t __attribute__((ext_vector_type(2)));
__device__ __forceinline__ unsigned cvtpk_s(float lo, float hi) { f32x2_t v = {lo, hi}; bf16x2_t b = __builtin_convertvector(v, bf16x2_t); return __builtin_bit_cast(unsigned, b); }
__device__ __forceinline__ v4i16_t vtr(const LAS unsigned char* p) { return __builtin_amdgcn_ds_read_tr16_b64_v4i16((LAS v4i16_t*)p); }
__device__ __forceinline__ void norm_frags(const bf16x8 (&raw)[4], const float* nw, int hf, float extra, bf16x8 (&out)[4]) {
    float ss = 0.f;
#pragma unroll
    for (int s = 0; s < 4; ++s)
#pragma unroll
        for (int j = 0; j < 8; ++j) { const float f = bf2f((unsigned short)raw[s][j]); ss += f * f; }
    ss += __shfl_xor(ss, 32);
    const float rs = extra / sqrtf(ss * (1.0f / 64) + EPS);
#pragma unroll
    for (int s = 0; s < 4; ++s) { const f32x4 w0 = *(const f32x4*)(nw + 16 * s + 8 * hf), w1 = *(const f32x4*)(nw + 16 * s + 8 * hf + 4);
        u32x4 o;
        o.x = cvtpk_s(bf2f((unsigned short)raw[s][0]) * rs * w0.x, bf2f((unsigned short)raw[s][1]) * rs * w0.y); o.y = cvtpk_s(bf2f((unsigned short)raw[s][2]) * rs * w0.z, bf2f((unsigned short)raw[s][3]) * rs * w0.w);
        o.z = cvtpk_s(bf2f((unsigned short)raw[s][4]) * rs * w1.x, bf2f((unsigned short)raw[s][5]) * rs * w1.y); o.w = cvtpk_s(bf2f((unsigned short)raw[s][6]) * rs * w1.z, bf2f((unsigned short)raw[s][7]) * rs * w1.w);
        out[s] = __builtin_bit_cast(bf16x8, o); }
}
constexpr int ATT_KOFF = 0, ATT_VOFF = 2 * ATT_VB, ATT_SSQ2 = 4 * ATT_VB;
__device__ __forceinline__ void mixer_unit(const bf16_t* P, const float* conv_w, const float* cnw, const float* qnw, const float* knw, const float* sinks, const float* anw, bf16_t* ymix, int t0, LAS unsigned char* lds, int wave, int lane) {
    constexpr float LOG2E = 1.4426950408889634f;
    const int tid = threadIdx.x, s0 = t0 % SEQ, kb0 = t0 - 128;
    const int tw = t0 + 4 * wave, sw = tw % SEQ, c0 = lane * 8;
    bf16x8 cg[6], hh[6], bg[4];
#pragma unroll
    for (int j = 0; j < 6; ++j) { int row = tw - 2 + j; row = row < 0 ? 0 : row; const bf16_t* rp = P + (size_t)row * NPROJ; cg[j] = *(const bf16x8*)(rp + OFF_C + c0); hh[j] = *(const bf16x8*)(rp + OFF_H + c0); }
#pragma unroll
    for (int j = 0; j < 4; ++j) bg[j] = *(const bf16x8*)(P + (size_t)(tw + j) * NPROJ + OFF_B + c0);
    u32x4 kreg[5], vreg[5];
#pragma unroll
    for (int i = 0; i < 5; ++i) { const int idx = tid + i * 512, piece = idx & 7, key = (idx >> 3) % 160, kvh = idx / 1280; int row = kb0 + key; row = row < 0 ? 0 : row;
        const bf16_t* rp = P + (size_t)row * NPROJ + kvh * 64 + piece * 8; kreg[i] = *(const u32x4*)(rp + OFF_K); vreg[i] = *(const u32x4*)(rp + OFF_V); }
    const int h = wave, kvh = h >> 2, r = lane & 31, hf = lane >> 5;
    bf16x8 qraw[4];
    { const bf16_t* qp = P + (size_t)(t0 + r) * NPROJ + OFF_Q + h * 64 + 8 * hf;
#pragma unroll
      for (int s = 0; s < 4; ++s) qraw[s] = *(const bf16x8*)(qp + 16 * s); }
    { float u[6][8];
#pragma unroll
      for (int j = 0; j < 6; ++j) { const bool ok = (sw - 2 + j) >= 0;
#pragma unroll
          for (int q = 0; q < 8; ++q) u[j][q] = ok ? bf2f((unsigned short)cg[j][q]) * bf2f((unsigned short)hh[j][q]) : 0.f; }
      float w0[8], w1[8], w2[8], nwv[8];
#pragma unroll
      for (int q = 0; q < 8; q += 4) { const f32x4 a = *(const f32x4*)(conv_w + c0 + q), b = *(const f32x4*)(conv_w + DCONV + c0 + q), c = *(const f32x4*)(conv_w + 2 * DCONV + c0 + q), n = *(const f32x4*)(cnw + c0 + q);
          w0[q] = a.x; w0[q + 1] = a.y; w0[q + 2] = a.z; w0[q + 3] = a.w; w1[q] = b.x; w1[q + 1] = b.y; w1[q + 2] = b.z; w1[q + 3] = b.w;
          w2[q] = c.x; w2[q + 1] = c.y; w2[q + 2] = c.z; w2[q + 3] = c.w; nwv[q] = n.x; nwv[q + 1] = n.y; nwv[q + 2] = n.z; nwv[q + 3] = n.w; }
      float y[4][8], ss[4];
#pragma unroll
      for (int i = 0; i < 4; ++i) { ss[i] = 0.f;
#pragma unroll
          for (int q = 0; q < 8; ++q) { const float v = w0[q] * u[i][q] + w1[q] * u[i + 1][q] + w2[q] * u[i + 2][q]; y[i][q] = v * bf2f((unsigned short)bg[i][q]); ss[i] += y[i][q] * y[i][q]; } }
#pragma unroll
      for (int o = 1; o < 64; o <<= 1) {
#pragma unroll
          for (int i = 0; i < 4; ++i) ss[i] += __shfl_xor(ss[i], o); }
#pragma unroll
      for (int i = 0; i < 4; ++i) { const float rstd = 1.0f / sqrtf(ss[i] * (1.0f / DCONV) + EPS); u32x4 o;
          o.x = cvtpk_s(y[i][0] * rstd * nwv[0], y[i][1] * rstd * nwv[1]); o.y = cvtpk_s(y[i][2] * rstd * nwv[2], y[i][3] * rstd * nwv[3]);
          o.z = cvtpk_s(y[i][4] * rstd * nwv[4], y[i][5] * rstd * nwv[5]); o.w = cvtpk_s(y[i][6] * rstd * nwv[6], y[i][7] * rstd * nwv[7]);
          *(u32x4*)(ymix + (size_t)(tw + i) * D + c0) = o; } }
    { const int piece = tid & 7; const f32x4 kw0 = *(const f32x4*)(knw + piece * 8), kw1 = *(const f32x4*)(knw + piece * 8 + 4);
#pragma unroll
      for (int i = 0; i < 5; ++i) { const int idx = tid + i * 512, key = (idx >> 3) % 160, kv = idx / 1280;
          float f[8];
#pragma unroll
          for (int q = 0; q < 4; ++q) { f[2 * q] = __builtin_bit_cast(float, kreg[i][q] << 16); f[2 * q + 1] = __builtin_bit_cast(float, kreg[i][q] & 0xffff0000u); }
          float ss = (f[0] * f[0] + f[1] * f[1]) + (f[2] * f[2] + f[3] * f[3]) + (f[4] * f[4] + f[5] * f[5]) + (f[6] * f[6] + f[7] * f[7]);
          ss += __shfl_xor(ss, 1); ss += __shfl_xor(ss, 2); ss += __shfl_xor(ss, 4);
          const float rs = 1.0f / sqrtf(ss * (1.0f / 64) + EPS);
          u32x4 o; o.x = cvtpk_s(f[0] * rs * kw0.x, f[1] * rs * kw0.y); o.y = cvtpk_s(f[2] * rs * kw0.z, f[3] * rs * kw0.w); o.z = cvtpk_s(f[4] * rs * kw1.x, f[5] * rs * kw1.y); o.w = cvtpk_s(f[6] * rs * kw1.z, f[7] * rs * kw1.w);
          *(LAS u32x4*)(lds + ATT_KOFF + kv * ATT_VB + key * 128 + ((piece ^ (key & 7)) * 16)) = o;
          *(LAS u32x4*)(lds + ATT_VOFF + kv * ATT_VB + key * 128 + piece * 16) = vreg[i]; } }
    bf16x8 qf[4];
    norm_frags(qraw, qnw, hf, 0.125f * LOG2E, qf);
    __syncthreads();
    const float slope2 = exp2f(-(float)(h + 1)) * LOG2E, sink2 = sinks[h] * LOG2E;
    const int jmin = (128 - s0) > 0 ? (128 - s0) : 0;
    const int dmax = (r + 128 - jmin) < (WIN - 1) ? (r + 128 - jmin) : (WIN - 1);
    float mx = sink2;
    f32x16 p[5];
#pragma unroll
    for (int kb = 0; kb < 5; ++kb) { const int key = 32 * kb + r; const LAS unsigned char* krow = lds + ATT_KOFF + kvh * ATT_VB + key * 128;
#pragma unroll
        for (int i = 0; i < 16; ++i) p[kb][i] = 0.f;
#pragma unroll
        for (int s = 0; s < 4; ++s) { const bf16x8 kf = *(const LAS bf16x8*)(krow + (((2 * s + hf) ^ (key & 7)) * 16)); p[kb] = __builtin_amdgcn_mfma_f32_32x32x16_bf16(kf, qf[s], p[kb], 0, 0, 0); }
        int bk = r + 128 - 32 * kb - 4 * hf; asm volatile("" : "+v"(bk));
        const float sb = slope2 * (float)bk;
#pragma unroll
        for (int i = 0; i < 16; ++i) { const int ci = (i & 3) + 8 * (i >> 2); const int dist = bk - ci; const bool valid = (unsigned)dist <= (unsigned)dmax;
            const float v = valid ? p[kb][i] + (slope2 * (float)ci - sb) : -INFINITY; p[kb][i] = v; mx = fmaxf(mx, v); } }
    mx = fmaxf(mx, __shfl_xor(mx, 32));
    float l = 0.f;
#pragma unroll
    for (int kb = 0; kb < 5; ++kb)
#pragma unroll
        for (int i = 0; i < 16; ++i) { const float e = exp2f(p[kb][i] - mx); p[kb][i] = e; l += e; }
    l += __shfl_xor(l, 32); l += exp2f(sink2 - mx);
    f32x16 o[2];
#pragma unroll
    for (int i = 0; i < 16; ++i) { o[0][i] = 0.f; o[1][i] = 0.f; }
    { const int i16 = lane & 15, tq = i16 >> 2, tp = i16 & 3, blk = (lane >> 4) & 1;
      const LAS unsigned char* vb = lds + ATT_VOFF + kvh * ATT_VB + (4 * hf + tq) * 128 + (16 * blk + 4 * tp) * 2;
#pragma unroll
      for (int kb = 0; kb < 5; ++kb)
#pragma unroll
          for (int sp = 0; sp < 2; ++sp) { u32x4 pw;
              pw.x = cvtpk_s(p[kb][8 * sp + 0], p[kb][8 * sp + 1]); pw.y = cvtpk_s(p[kb][8 * sp + 2], p[kb][8 * sp + 3]); pw.z = cvtpk_s(p[kb][8 * sp + 4], p[kb][8 * sp + 5]); pw.w = cvtpk_s(p[kb][8 * sp + 6], p[kb][8 * sp + 7]);
              const bf16x8 pf = __builtin_bit_cast(bf16x8, pw);
#pragma unroll
              for (int db = 0; db < 2; ++db) { const LAS unsigned char* a = vb + (32 * kb + 16 * sp) * 128 + db * 64;
                  const v4i16_t lo = vtr(a), hi = vtr(a + 8 * 128);
                  const bf16x8 vf = (bf16x8){lo[0], lo[1], lo[2], lo[3], hi[0], hi[1], hi[2], hi[3]};
                  o[db] = __builtin_amdgcn_mfma_f32_32x32x16_bf16(vf, pf, o[db], 0, 0, 0); } } }
    const float il = 1.0f / l; float ss = 0.f;
#pragma unroll
    for (int db = 0; db < 2; ++db)
#pragma unroll
        for (int i = 0; i < 16; ++i) { o[db][i] *= il; ss += o[db][i] * o[db][i]; }
    ss += __shfl_xor(ss, 32);
    LAS float* ssq = (LAS float*)(lds + ATT_SSQ2);
    if (hf == 0) ssq[r * 8 + h] = ss;
    __syncthreads();
    float tot = 0.f;
#pragma unroll
    for (int hh2 = 0; hh2 < 8; ++hh2) tot += ssq[r * 8 + hh2];
    const float rstd = 1.0f / sqrtf(tot * (1.0f / DATT) + EPS);
    bf16_t* op = ymix + (size_t)(t0 + r) * D + DCONV + h * 64 + 4 * hf;
#pragma unroll
    for (int db = 0; db < 2; ++db)
#pragma unroll
        for (int g = 0; g < 4; ++g) { const f32x4 w = *(const f32x4*)(anw + h * 64 + db * 32 + 8 * g + 4 * hf);
            const unsigned lo = cvtpk_s(o[db][4 * g] * rstd * w.x, o[db][4 * g + 1] * rstd * w.y), hi = cvtpk_s(o[db][4 * g + 2] * rstd * w.z, o[db][4 * g + 3] * rstd * w.w);
            *(unsigned long long*)(op + db * 32 + 8 * g) = (unsigned long long)lo | ((unsigned long long)hi << 32); }
    __syncthreads();
}

constexpr int RT_CH = 32768;
constexpr int RT_W = 2 * RT_CH;
constexpr int RT_SCR = 2304;
__device__ __forceinline__ unsigned sort_key(float v) { const unsigned u = __builtin_bit_cast(unsigned, v); return u ^ ((unsigned)((int)u >> 31) | 0x80000000u); }
__device__ __forceinline__ void route_block(const float* x1, const bf16_t* Wr  , const float* rbias, float* rstd2, unsigned* cnt, int* tok, float* wl, float* rl, int* inv,
                                            int tb  , LAS unsigned char* lds, int wave, int lane) {
    const int tid = threadIdx.x, row = lane & 15, kg = lane >> 4, t0 = tb + 8 * wave;
    LAS float* lg = (LAS float*)(lds + RT_W + wave * RT_SCR); LAS float* srs = lg + 512;
    const float* xp = x1 + (size_t)(t0 + (row & 7)) * D + 8 * kg;
    f32x4 acc[4]; float ss = 0.f;
#pragma unroll
    for (int nb = 0; nb < 4; ++nb) acc[nb] = (f32x4){0.f, 0.f, 0.f, 0.f};
    f32x4 xv[4][2], xn[4][2]; v4u wv[4], wn[4];
#define RT_LOADX(c, XD) do { _Pragma("unroll") for (int s = 0; s < 4; ++s) { XD[s][0] = *(const f32x4*)(xp + 128 * (c) + 32 * s); XD[s][1] = *(const f32x4*)(xp + 128 * (c) + 32 * s + 4); } } while (0)
#define RT_LOADW(c, WD) do { _Pragma("unroll") for (int i = 0; i < 4; ++i) { const int id = tid + i * 512, p = id & 15, e = (id >> 4) & 63, part = id >> 10; \
            WD[i] = *(const v4u*)(Wr + (size_t)part * NE * D + (size_t)e * D + 128 * (c) + 8 * p); } } while (0)
    RT_LOADX(0, xv); RT_LOADW(0, wv);
#pragma unroll
    for (int c = 0; c < 8; ++c) {
        LAS unsigned char* buf = lds + (c & 1) * RT_CH;
#pragma unroll
        for (int i = 0; i < 4; ++i) { const int id = tid + i * 512, p = id & 15, e = (id >> 4) & 63, part = id >> 10;
            *(LAS v4u*)(buf + part * 16384 + e * 256 + ((p ^ (e & 15)) * 16)) = wv[i]; }
        __syncthreads();
        if (c < 7) { RT_LOADX(c + 1, xn); RT_LOADW(c + 1, wn); }
#pragma unroll
        for (int s = 0; s < 4; ++s) {
            const f32x4 v0 = xv[s][0], v1 = xv[s][1];
            ss += (v0.x * v0.x + v0.y * v0.y) + (v0.z * v0.z + v0.w * v0.w) + (v1.x * v1.x + v1.y * v1.y) + (v1.z * v1.z + v1.w * v1.w);
            u32x4 hw, lw;
            hw.x = cvtpk_s(v0.x, v0.y); hw.y = cvtpk_s(v0.z, v0.w); hw.z = cvtpk_s(v1.x, v1.y); hw.w = cvtpk_s(v1.z, v1.w);
            lw.x = cvtpk_s(v0.x - __builtin_bit_cast(float, hw.x << 16), v0.y - __builtin_bit_cast(float, hw.x & 0xffff0000u));
            lw.y = cvtpk_s(v0.z - __builtin_bit_cast(float, hw.y << 16), v0.w - __builtin_bit_cast(float, hw.y & 0xffff0000u));
            lw.z = cvtpk_s(v1.x - __builtin_bit_cast(float, hw.z << 16), v1.y - __builtin_bit_cast(float, hw.z & 0xffff0000u));
            lw.w = cvtpk_s(v1.z - __builtin_bit_cast(float, hw.w << 16), v1.w - __builtin_bit_cast(float, hw.w & 0xffff0000u));
            const bf16x8 xh = __builtin_bit_cast(bf16x8, hw), xl = __builtin_bit_cast(bf16x8, lw);
#pragma unroll
            for (int nb = 0; nb < 4; ++nb) { const int e = 16 * nb + row, p = 4 * s + kg; const int off = e * 256 + ((p ^ (e & 15)) * 16);
                const bf16x8 wh = *(const LAS bf16x8*)(buf + off), wlo = *(const LAS bf16x8*)(buf + 16384 + off);
                acc[nb] = __builtin_amdgcn_mfma_f32_16x16x32_bf16(xh, wh, acc[nb], 0, 0, 0);
                acc[nb] = __builtin_amdgcn_mfma_f32_16x16x32_bf16(xl, wh, acc[nb], 0, 0, 0);
                acc[nb] = __builtin_amdgcn_mfma_f32_16x16x32_bf16(xh, wlo, acc[nb], 0, 0, 0); }
        }
        if (c < 7) {
#pragma unroll
            for (int s = 0; s < 4; ++s) { xv[s][0] = xn[s][0]; xv[s][1] = xn[s][1]; wv[s] = wn[s]; } }
    }
#undef RT_LOADX
#undef RT_LOADW
    __syncthreads();
    ss += __shfl_xor(ss, 16); ss += __shfl_xor(ss, 32);
    const float rstd = 1.0f / sqrtf(ss * (1.0f / D) + EPS);
    if (kg == 0 && row < 8) { rstd2[t0 + row] = rstd; srs[row] = rstd; }
    if (kg < 2) {
#pragma unroll
        for (int nb = 0; nb < 4; ++nb)
#pragma unroll
            for (int i = 0; i < 4; ++i) lg[(4 * kg + i) * 64 + 16 * nb + row] = acc[nb][i]; }
    LDS_WAIT(); asm volatile("" ::: "memory");
    const int tk = lane >> 3, g = lane & 7;
    const float rs = srs[tk];
    float sc[8]; unsigned ck[8];
    { const f32x4 l0 = *(const LAS f32x4*)(lg + tk * 64 + 8 * g), l1 = *(const LAS f32x4*)(lg + tk * 64 + 8 * g + 4);
      const f32x4 b0 = *(const f32x4*)(rbias + 8 * g), b1 = *(const f32x4*)(rbias + 8 * g + 4);
      const float lr[8] = {l0.x, l0.y, l0.z, l0.w, l1.x, l1.y, l1.z, l1.w}, bb[8] = {b0.x, b0.y, b0.z, b0.w, b1.x, b1.y, b1.z, b1.w};
      float m1 = -INFINITY, m2 = -INFINITY;
#pragma unroll
      for (int i = 0; i < 8; ++i) { sc[i] = 1.0f / (1.0f + __expf(-lr[i] * rs)); const float bz = sc[i] + bb[i];
          ck[i] = (sort_key(bz) & ~63u) | (unsigned)(63 - (8 * g + i));
          if (bz > m1) { m2 = m1; m1 = bz; } else if (bz > m2) m2 = bz; }
      const unsigned gk = (sort_key(m1 + m2) & ~7u) | (unsigned)(7 - g); int grank = 0;
#pragma unroll
      for (int d = 1; d < 8; ++d) grank += ((unsigned)__shfl_xor((int)gk, d) > gk) ? 1 : 0;
      if (grank >= TOPG) {
#pragma unroll
          for (int i = 0; i < 8; ++i) ck[i] = 0u; } }
    unsigned selbits = 0u;
#pragma unroll
    for (int r = 0; r < TOPK; ++r) {
        unsigned m = ck[0];
#pragma unroll
        for (int i = 1; i < 8; ++i) m = m > ck[i] ? m : ck[i];
        unsigned o = (unsigned)__shfl_xor((int)m, 1); m = m > o ? m : o; o = (unsigned)__shfl_xor((int)m, 2); m = m > o ? m : o; o = (unsigned)__shfl_xor((int)m, 4); m = m > o ? m : o;
#pragma unroll
        for (int i = 0; i < 8; ++i) { const bool hit = ck[i] == m; selbits |= hit ? (1u << i) : 0u; ck[i] = hit ? 0u : ck[i]; }
    }
    float ssum = 0.f;
#pragma unroll
    for (int i = 0; i < 8; ++i) ssum += ((selbits >> i) & 1u) ? sc[i] : 0.f;
    ssum += __shfl_xor(ssum, 1); ssum += __shfl_xor(ssum, 2); ssum += __shfl_xor(ssum, 4);
    const float wscale = RSCALE / ssum;
    unsigned long long bal[8];
#pragma unroll
    for (int i = 0; i < 8; ++i) bal[i] = __ballot((selbits >> i) & 1u);
    unsigned long long mb = 0ull;
#pragma unroll
    for (int i = 0; i < 8; ++i) mb = ((lane & 7) == i) ? bal[i] : mb;
    const unsigned long long gmask_own = 0x0101010101010101ull << (lane >> 3);
    const int necnt = __popcll(mb & gmask_own);
    LAS int* cw = (LAS int*)(lds + RT_W + 8 * RT_SCR); LAS unsigned* cb = (LAS unsigned*)(cw + 8 * 64);
    cw[wave * 64 + lane] = necnt;
    __syncthreads();
    if (wave == 0) { int tot = 0;
#pragma unroll
        for (int w = 0; w < 8; ++w) tot += cw[w * 64 + lane];
        unsigned b = 0u; if (tot) b = atomicAdd(&cnt[lane * CSTR], (unsigned)tot); cb[lane] = b; }
    __syncthreads();
    unsigned base = cb[lane];
    for (int w = 0; w < wave; ++w) base += (unsigned)cw[w * 64 + lane];
    const int nself = __popc(selbits); int kpre = 0;
#pragma unroll
    for (int d = 1; d < 8; ++d) { const int o = __shfl_xor(nself, d); kpre += ((g ^ d) < g) ? o : 0; }
    const unsigned long long gmask = 0x0101010101010101ull << g, below = (1ull << lane) - 1ull;
#pragma unroll
    for (int i = 0; i < 8; ++i) { const unsigned eb = (unsigned)__shfl((int)base, 8 * g + i);
        if ((selbits >> i) & 1u) { const int e = 8 * g + i; const unsigned pos = eb + (unsigned)__popcll(bal[i] & gmask & below); const size_t li = (size_t)e * LISTCAP + pos;
            tok[li] = t0 + tk; wl[li] = sc[i] * wscale; rl[li] = rs; inv[(size_t)(t0 + tk) * TOPK + kpre + __popc(selbits & ((1u << i) - 1u))] = (e << 16) | (int)pos; } }
    LDS_WAIT(); asm volatile("" ::: "memory");
}

__device__ __forceinline__ void build_group_tables(LAS unsigned char* lds, const unsigned* cnt, int& ntiles) {
    LAS int* tpre = (LAS int*)(lds + TPRE_OFF); LAS int* rpre = (LAS int*)(lds + RPRE_OFF); LAS int* ncnt = (LAS int*)(lds + NCNT_OFF); LAS unsigned short* tile_e = (LAS unsigned short*)(lds + TILEE_OFF);
    LAS int* cpre = (LAS int*)(lds + CPRE_OFF); LAS unsigned short* chunk_e = (LAS unsigned short*)(lds + CHE_OFF);
    if (threadIdx.x < 64) {
        const int lane = threadIdx.x; const int n = (int)cnt[lane * CSTR], tl = (n + 255) >> 8, nc = (tl + DCH - 1) / DCH; int rp = n, tp = tl, cp = nc;
#pragma unroll
        for (int o = 1; o < 64; o <<= 1) { const int a = __shfl_up(rp, o), b = __shfl_up(tp, o), c = __shfl_up(cp, o); if (lane >= o) { rp += a; tp += b; cp += c; } }
        tpre[lane] = tp - tl; rpre[lane] = rp - n; ncnt[lane] = n; cpre[lane] = cp - nc;
        if (lane == 63) { tpre[NE] = tp; rpre[NE] = rp; ncnt[NE] = M; tpre[NEX] = tp + (M >> 8); rpre[NEX] = rp + M; ncnt[NEX] = 0; cpre[NE] = cp; cpre[NEX] = cp + ((M >> 8) + DCH - 1) / DCH; } }
    __syncthreads();
    ntiles = tpre[NEX];
    for (int e = threadIdx.x >> 3; e < NEX; e += 64) { const int a = cpre[e], b = cpre[e + 1]; for (int t = a + (threadIdx.x & 7); t < b; t += 8) chunk_e[t] = (unsigned short)e; }
    for (int e = threadIdx.x >> 3; e < NEX; e += 64) { const int a = tpre[e], b = tpre[e + 1]; for (int t = a + (threadIdx.x & 7); t < b; t += 8) tile_e[t] = (unsigned short)e; }
    __syncthreads();
}

__device__ __forceinline__ void combine_tokens2(const unsigned char* y, const LAS int* rpre, const int* inv, const float* x1, float* outw, int t, int tw, int lane) {
    typedef int i32x4 __attribute__((ext_vector_type(4)));
    i32x4 ip[2][2];
#pragma unroll
    for (int q = 0; q < 2; ++q) { ip[q][0] = *(const i32x4*)(inv + (size_t)(t + q) * TOPK); ip[q][1] = *(const i32x4*)(inv + (size_t)(t + q) * TOPK + 4); }
    u32x4 v[2][9]; f32x4 o[2][4];
#pragma unroll
    for (int q = 0; q < 2; ++q) {
#pragma unroll
        for (int k = 0; k < TOPK; ++k) { const int w = ip[q][k >> 2][k & 3]; const int row = rpre[w >> 16] + (w & 0xffff); v[q][k] = *(const u32x4*)(y + (size_t)row * D + lane * 16); }
        v[q][8] = *(const u32x4*)(y + (size_t)(NSLOT + t + q) * D + lane * 16);
        const float* op = x1 + (size_t)(t + q) * D + lane * 16;
#pragma unroll
        for (int c = 0; c < 4; ++c) o[q][c] = *(const f32x4*)(op + 4 * c); }
#pragma unroll
    for (int q = 0; q < 2; ++q) { float a[16];
#pragma unroll
        for (int j = 0; j < 16; ++j) a[j] = 0.f;
#pragma unroll
        for (int k = 0; k < 9; ++k)
#pragma unroll
            for (int c = 0; c < 4; ++c) { const f32x2_t lo = __builtin_amdgcn_cvt_pk_f32_fp8((int)v[q][k][c], false), hi = __builtin_amdgcn_cvt_pk_f32_fp8((int)v[q][k][c], true);
                a[4 * c] += lo.x; a[4 * c + 1] += lo.y; a[4 * c + 2] += hi.x; a[4 * c + 3] += hi.y; }
        float* ow = outw + (size_t)(tw + q) * D + lane * 16;
#pragma unroll
        for (int c = 0; c < 4; ++c) { f32x4 r = o[q][c]; r.x += a[4 * c] * (1.0f / YSCALE); r.y += a[4 * c + 1] * (1.0f / YSCALE); r.z += a[4 * c + 2] * (1.0f / YSCALE); r.w += a[4 * c + 3] * (1.0f / YSCALE); *(f32x4*)(ow + 4 * c) = r; } }
}

constexpr int I_IN = (D / 64) * (NPROJ / 64), I_OUT = (D / 64) * (D / 64), I_G = (D / 128) * (DE / 32), I_D = (DE / 128) * (D / 32);
constexpr int P0_NITEMS = I_IN + I_OUT + NEX * (2 * I_G + I_D);
#ifndef P0_DEFER
#define P0_DEFER 12480
#endif
#ifndef CONV_MASK16
#define CONV_MASK16 0xA4A4u
#endif
constexpr int P0_NKEEP = P0_NITEMS - P0_DEFER;
__device__ __forceinline__ void p0_item(const Args& args, unsigned char* ws, int it, LAS float* scr, int lane) {
    unsigned char* Wtd = ws + WS_WTD; bf16_t* Wtin = (bf16_t*)(ws + WS_WTIN); bf16_t* Wtout = (bf16_t*)(ws + WS_WTOUT); unsigned char* Wtgu = ws + WS_WTGU;
    int r = it;
    if (r < I_IN) { p0_transpose_item<false>(args.in[2], D, NPROJ, Wtin, 0, nullptr, scr, r, lane); return; } r -= I_IN;
    if (r < I_OUT) { p0_transpose_item<false>(args.in[9], D, D, Wtout, 0, nullptr, scr, r, lane); return; } r -= I_OUT;
    const int e = r / (2 * I_G + I_D); r -= e * (2 * I_G + I_D);
    const float* sg_ = (e < NE) ? args.in[13] + (size_t)e * D * DE : args.in[16]; const float* su_ = (e < NE) ? args.in[14] + (size_t)e * D * DE : args.in[17]; const float* sd_ = (e < NE) ? args.in[15] + (size_t)e * D * DE : args.in[18];
    if (r < I_G) { p0_transpose_item8<true>(sg_, D, DE, Wtgu + (size_t)e * 512 * D, 1, args.in[10], GU_SCALE, scr, r, lane); return; } r -= I_G;
    if (r < I_G) { p0_transpose_item8<true>(su_, D, DE, Wtgu + (size_t)e * 512 * D, 2, args.in[10], GU_SCALE, scr, r, lane); return; } r -= I_G;
    p0_transpose_item8<false>(sd_, DE, D, Wtd + (size_t)e * D * DE, 0, nullptr, DN_SCALE, scr, r, lane);
}

#ifndef REP_MASK
#define REP_MASK 0
#endif
#define REPS(k) (1 + ((REP_MASK >> (k)) & 1))
#ifdef TPH
#define TSTAMP(k) do { if (((k) == TPH || (k) == TPH + 1) && blockIdx.x == 0 && tid == 0) { const unsigned long long t_ = __builtin_amdgcn_s_memrealtime(); MISC[16 + 2 * ((k) - TPH)] = (unsigned)t_; MISC[17 + 2 * ((k) - TPH)] = (unsigned)(t_ >> 32); } } while (0)
#else
#define TSTAMP(k) do { } while (0)
#endif
constexpr int N_PHASES = 11;
__global__ void __launch_bounds__(NWAVES * 64, 2) mega_fwd(Args args) {
    extern __shared__ __attribute__((aligned(16))) unsigned char lds_raw[];
    LAS unsigned char* lds = (LAS unsigned char*)lds_raw;
    volatile LAS unsigned* MISC = (volatile LAS unsigned*)(lds + MISC_OFF);
    const int tid = threadIdx.x, lane = tid & 63, wave = __builtin_amdgcn_readfirstlane(tid >> 6);
    const int G = gridDim.x; const int bx = blockIdx.x; const int vcu = (G % 8 == 0) ? (bx % 8) * (G / 8) + bx / 8 : bx;
    unsigned char* ws = args.ws;
    gu32* ctl = (gu32*)(ws + WS_CTL);
    float* out = args.out;
    unsigned* cnt = (unsigned*)(ws + WS_CTL) + CW_CNT;
    int* tok = (int*)(ws + WS_TOK); float* wl = (float*)(ws + WS_WL); int* inv = (int*)(ws + WS_INV);
    bf16_t* Wtd = (bf16_t*)(ws + WS_WTD); bf16_t* P = (bf16_t*)(ws + WS_P); bf16_t* hb = (bf16_t*)(ws + WS_HB); bf16_t* Wtin = (bf16_t*)(ws + WS_WTIN);
    bf16_t* Wtout = (bf16_t*)(ws + WS_WTOUT); bf16_t* Wtgu = (bf16_t*)(ws + WS_WTGU); bf16_t* U = (bf16_t*)(ws + WS_U); bf16_t* ymix = (bf16_t*)(ws + WS_YMIX); bf16_t* Y = (bf16_t*)(ws + WS_Y);

    for (int u = tid; u < 32; u += NWAVES * 64) ((LAS unsigned*)(lds + MISC_OFF))[u] = 0u;
    __syncthreads();
    const int lo = args.ph_lo, hi = args.ph_hi;
    const bool use_bar = (hi - lo) > 1;
    XcdBarrier bar; bar.bar = (unsigned*)(ctl + CW_BAR); bar.x = 0; bar.st = nullptr;
    if (use_bar) bar = xcd_barrier_post((unsigned*)(ctl + CW_BAR), MISC + 8);
#define IN(k) (lo <= (k) && (k) < hi)
#define SEAM(k) do { if (IN(k) && IN((k) + 1)) xcd_barrier(bar); } while (0)
    const int gw = vcu * NWAVES + wave, NGW = G * NWAVES;

    TSTAMP(0);
    if (IN(0)) for (int rep_ = 0; rep_ < REPS(0); ++rep_) {
        LAS float* scr = (LAS float*)(lds + wave * P0SCR);
        for (int it = gw; it < P0_NKEEP; it += NGW) p0_item(args, ws, it, scr, lane);
        { bf16_t* Wr = (bf16_t*)(ws + WS_WR); const float* wrt = args.in[11]; const float* fw = args.in[10];
          for (int i = (vcu * NWAVES + wave) * 64 + lane; i < NE * (D / 8); i += NGW * 64) { const int e = i & 63, k8 = (i >> 6) * 8; unsigned hh[4], ll[4];
#pragma unroll
              for (int j = 0; j < 4; ++j) { const float a = wrt[(size_t)(k8 + 2 * j) * NE + e] * fw[k8 + 2 * j], b = wrt[(size_t)(k8 + 2 * j + 1) * NE + e] * fw[k8 + 2 * j + 1];
                  const unsigned ha = f2bf(a), hb2 = f2bf(b); hh[j] = ha | (hb2 << 16); ll[j] = f2bf(a - bf2f((unsigned short)ha)) | (f2bf(b - bf2f((unsigned short)hb2)) << 16); }
              *(v4u*)(Wr + (size_t)e * D + k8) = (v4u){hh[0], hh[1], hh[2], hh[3]}; *(v4u*)(Wr + (size_t)NE * D + (size_t)e * D + k8) = (v4u){ll[0], ll[1], ll[2], ll[3]}; } }
        for (int m = 2 * gw; m < M; m += 2 * NGW) rms_rows2_to_bf16(args.in[0] + (size_t)m * D, args.in[0] + (size_t)(m + 1) * D, args.in[1], U + (size_t)m * D, U + (size_t)(m + 1) * D, lane);
    }
    SEAM(0); TSTAMP(1);
    if (IN(1)) for (int rep_ = 0; rep_ < REPS(1); ++rep_) {
        const int xs = bx >> 3, xc = bx & 7; const bool split = (G == 256) && (P0_DEFER > 0);
        constexpr unsigned CM = CONV_MASK16; constexpr int NCV = __builtin_popcount(CM) * 16, NGM = 256 - NCV;
        const int below = __builtin_popcount(CM & ((1u << (xs & 15)) - 1u)) + __builtin_popcount(CM) * (xs >> 4);
        if (split && ((CM >> (xs & 15)) & 1u)) {
            LAS float* scr = (LAS float*)(lds + wave * P0SCR); const int q = xc + 8 * below;
            for (int it = P0_NKEEP + q * NWAVES + wave; it < P0_NITEMS; it += NCV * NWAVES) p0_item(args, ws, it, scr, lane);
        } else {
            pg8::DenseOrder S; if (split) S.init(U, Wtin, M, NPROJ, D, NGM, xc + 8 * (xs - below)); else S.init(U, Wtin, M, NPROJ, D, G, bx);
            pg8::EpiBf16 E{P, NPROJ};
            pg8::gemm_phase<pg8::EpiBf16, pg8::DenseOrder, true>(lds, D, S, E);
        }
    }
    SEAM(1); TSTAMP(2);
    if (IN(2)) for (int rep_ = 0; rep_ < REPS(2); ++rep_) {
        for (int t0 = vcu * 32; t0 < M; t0 += G * 32) mixer_unit(P, args.in[3], args.in[7], args.in[4], args.in[5], args.in[6], args.in[8], ymix, t0, lds, wave, lane);
    }
    SEAM(2); TSTAMP(3);
    if (IN(3)) for (int rep_ = 0; rep_ < REPS(3); ++rep_) {
        pg8::DenseOrder S; S.init(ymix, Wtout, M, D, D, G, bx);
        pg8::EpiResF32 E{args.in[0], out, (unsigned char*)U, D};
        pg8::gemm_phase<pg8::EpiResF32, pg8::DenseOrder, false>(lds, D, S, E);
    }
    SEAM(3); TSTAMP(4);
    if (IN(4)) for (int rep_ = 0; rep_ < REPS(4); ++rep_) {
        const bf16_t* Wr = (const bf16_t*)(ws + WS_WR); float* rstd2 = (float*)(ws + WS_RSTD); float* rl = (float*)(ws + WS_RL);
        if (rep_ == 0) { for (int tb = vcu * 64; tb < M; tb += G * 64) route_block(out, Wr, args.in[12], rstd2, cnt, tok, wl, rl, inv, tb, lds, wave, lane); }
        else { unsigned char* dz = ws + WS_HB;
            for (int tb = vcu * 64; tb < M; tb += G * 64) route_block(out, Wr, args.in[12], (float*)(dz + 32 * MiB), cnt + 8192, (int*)dz, (float*)(dz + 8 * MiB), (float*)(dz + 24 * MiB), (int*)(dz + 16 * MiB), tb, lds, wave, lane); }
    }
    SEAM(4); TSTAMP(5);
    int ntiles = 0;
    if (IN(5) || IN(6) || IN(7)) build_group_tables(lds, cnt, ntiles);
    const LAS int* tpre = (const LAS int*)(lds + TPRE_OFF); const LAS int* rpre = (const LAS int*)(lds + RPRE_OFF); const LAS int* ncnt = (const LAS int*)(lds + NCNT_OFF);
    const LAS unsigned short* tile_e = (const LAS unsigned short*)(lds + TILEE_OFF);
    if (IN(5)) for (int rep_ = 0; rep_ < REPS(5); ++rep_) {
        pg8::GroupedOrder<true> S{tpre, rpre, ncnt, tile_e, (const char*)U, (const char*)Wtgu, tok, (size_t)512 * D, 2, 0, ntiles * 2, G, bx, D};
        pg8::EpiSwiglu E{(unsigned char*)hb, (const float*)(ws + WS_RL), (const float*)(ws + WS_RSTD)};
        pg8::gemm_phase<pg8::EpiSwiglu, pg8::GroupedOrder<true>, true, true>(lds, D, S, E);
    }
    SEAM(5); TSTAMP(6);
    unsigned char* Y8 = (unsigned char*)Y;
    if (IN(6)) for (int rep_ = 0; rep_ < REPS(6); ++rep_) {
        const LAS int* cpre = (const LAS int*)(lds + CPRE_OFF);
        pg8::Down DP{tpre, rpre, ncnt, cpre, (const LAS unsigned short*)(lds + CHE_OFF), (const unsigned char*)hb, (const unsigned char*)Wtd, wl, Y8, cpre[NEX] * 4, G, bx};
        pg8::down_phase(lds, DP);
    }
    SEAM(6); TSTAMP(7);
    if (IN(7)) for (int rep_ = 0; rep_ < REPS(7); ++rep_) { float* ow = rep_ == 0 ? out : (float*)(ws + WS_END); for (int t = 2 * gw; t < M; t += 2 * NGW) combine_tokens2(Y8, rpre, inv, out, ow, t, rep_ == 0 ? t : (t & 1023), lane); }
    TSTAMP(8);
#ifdef TPH
    if (blockIdx.x == 0 && tid == 0) { const unsigned long long t_a = MISC[16] | ((unsigned long long)MISC[17] << 32), t_b = MISC[18] | ((unsigned long long)MISC[19] << 32); const unsigned long long d = (t_b - t_a) * 10ull, t0 = __builtin_amdgcn_s_memrealtime(); while (__builtin_amdgcn_s_memrealtime() - t0 < d) __builtin_amdgcn_s_sleep(8); }
#endif
#undef IN
#undef SEAM
}

extern "C" void kernel_launch(void* const* d_in, const int* in_sizes, int n_in, void* d_out, int out_size, void* d_ws, size_t ws_size, hipStream_t stream) {
    static int grid = 0;
    if (grid == 0) {
        if (n_in != 19 || in_sizes[0] != M * D || out_size != M * D || ws_size < WS_END) { fprintf(stderr, "kernel_launch: unexpected shapes/ws (n_in %d, ws %zu)\n", n_in, ws_size); grid = -1; return; }
        int dev = 0, cus = 0, per_cu = 0;
        if (hipGetDevice(&dev) != hipSuccess || hipDeviceGetAttribute(&cus, hipDeviceAttributeMultiprocessorCount, dev) != hipSuccess) { grid = -1; return; }
        if (hipFuncSetAttribute((const void*)mega_fwd, hipFuncAttributeMaxDynamicSharedMemorySize, LDS_BYTES) != hipSuccess) { fprintf(stderr, "kernel_launch: hipFuncSetAttribute failed\n"); grid = -1; return; }
        if (hipOccupancyMaxActiveBlocksPerMultiprocessor(&per_cu, (const void*)mega_fwd, NWAVES * 64, LDS_BYTES) != hipSuccess || per_cu < 1) fprintf(stderr, "kernel_launch: occupancy query reports %d\n", per_cu);
        (void)hipGetLastError();
        grid = cus;
    }
    if (grid < 0) return;
    (void)hipMemsetAsync((char*)d_ws + WS_CTL, 0, 64 * 1024, stream);
    Args a{};
    for (int i = 0; i < 19; ++i) a.in[i] = (const float*)d_in[i];
    a.out = (float*)d_out; a.ws = (unsigned char*)d_ws;
#ifndef MK_SPLIT
    a.ph_lo = 0; a.ph_hi = 8;
    hipLaunchKernelGGL(mega_fwd, dim3(grid), dim3(NWAVES * 64), LDS_BYTES, stream, a);
#else
    for (int p = 0; p < 8; ++p) { a.ph_lo = p; a.ph_hi = p + 1; hipLaunchKernelGGL(mega_fwd, dim3(grid), dim3(NWAVES * 64), LDS_BYTES, stream, a); }
#endif
}
```

```cpp
#define P1_BAL2 1
#define P1_NA 6
#define P1_NB 0
#define P1_NC 5
#define SPLIT_SEAM0 1
#define SHADOW 4
#include <hip/hip_runtime.h>
#include <cstdio>
#include <cstdint>

#define GAS __attribute__((address_space(1)))
#define LAS __attribute__((address_space(3)))
typedef unsigned short bf16_t;
typedef short bf16x8 __attribute__((ext_vector_type(8)));
typedef float f32x16 __attribute__((ext_vector_type(16)));
typedef float f32x4 __attribute__((ext_vector_type(4)));
typedef unsigned u32x4 __attribute__((ext_vector_type(4)));
typedef unsigned v4u __attribute__((ext_vector_type(4)));
typedef GAS unsigned gu32;
typedef GAS unsigned long long gu64;
#define RLX_AGENT __ATOMIC_RELAXED, __HIP_MEMORY_SCOPE_AGENT
#define LDS_WAIT() asm volatile("s_waitcnt lgkmcnt(0)" ::: "memory")
#define VM_WAIT() asm volatile("s_waitcnt vmcnt(0)" ::: "memory")

constexpr int D = 1024, BATCH = 4, SEQ = 4096, M = BATCH * SEQ;
constexpr int DCONV = 512, HD = 64, NH = 8, NKV = 2, DATT = 512, DKV = 128, WIN = 128;
constexpr int NPROJ = 2304;
constexpr int OFF_B = 0, OFF_C = 512, OFF_H = 1024, OFF_Q = 1536, OFF_K = 2048, OFF_V = 2176;
constexpr int NE = 64, TOPK = 8, NG = 8, TOPG = 4, DE = 256;
constexpr float EPS = 1e-6f, RSCALE = 2.5f, YSCALE = 16.0f;
constexpr float GU_SCALE = 32.0f, DN_SCALE = 16.0f;
constexpr int NEX = NE + 1;
constexpr int NSLOT = M * TOPK;
constexpr int LISTCAP = M;
constexpr int MAXTILES = 704;

constexpr size_t MiB = 1u << 20;
constexpr size_t WS_CTL = 0;
constexpr size_t WS_TOK = 1 * MiB;
constexpr size_t WS_WL = 5 * MiB;
constexpr size_t WS_RL = 9 * MiB;
constexpr size_t WS_INV = 13 * MiB;
constexpr size_t WS_WR = 13 * MiB + 512 * 1024;
constexpr size_t WS_RSTD = WS_WR + 256 * 1024;
constexpr size_t WS_WTD = 14 * MiB;
constexpr size_t WS_P = 47 * MiB;
constexpr size_t WS_HB = 47 * MiB;
constexpr size_t WS_WTIN = 120 * MiB;
constexpr size_t WS_WTOUT = 125 * MiB;
constexpr size_t WS_WTGU = 127 * MiB;
constexpr size_t WS_U = 192 * MiB;
constexpr size_t WS_YMIX = 224 * MiB;
constexpr size_t WS_Y = 120 * MiB;
constexpr size_t WS_END = 265 * MiB;
constexpr int CW_CNT = 8192, CSTR = 64;
constexpr int CW_BAR = 4096;

constexpr int RING_BYTES = 131072;
constexpr int P0SCR = 16896;
constexpr int MISC_OFF = 8 * P0SCR;
constexpr int TPRE_OFF = MISC_OFF + 128;
constexpr int RPRE_OFF = TPRE_OFF + 272;
constexpr int NCNT_OFF = RPRE_OFF + 272;
constexpr int TILEE_OFF = NCNT_OFF + 272;
constexpr int CPRE_OFF = TILEE_OFF + MAXTILES * 2;
constexpr int CHE_OFF = CPRE_OFF + 272;
constexpr int DCH = 2, MAXCH = 768;
constexpr int LDS_BYTES = 147456;
static_assert(CHE_OFF + MAXCH * 2 <= LDS_BYTES, "LDS map");

__device__ __forceinline__ unsigned f2bf(float f) { unsigned u = __builtin_bit_cast(unsigned, f); return (u + 0x7fffu + ((u >> 16) & 1u)) >> 16; }
__device__ __forceinline__ unsigned pk2(float lo, float hi) { return f2bf(lo) | (f2bf(hi) << 16); }
__device__ __forceinline__ float bf2f(unsigned short b) { return __builtin_bit_cast(float, (unsigned)b << 16); }
__device__ __forceinline__ float wave_sum(float v) {
#pragma unroll
    for (int o = 1; o < 64; o <<= 1) v += __shfl_xor(v, o);
    return v;
}
__device__ __forceinline__ int crow(int reg, int h) { return (reg & 3) + 8 * (reg >> 2) + 4 * h; }
#define XB_TMO      128
#define XB_XCNT(j)  (256  + 64 * (j))
#define XB_XSUB(j)  (1280 + 64 * (j))
#define XB_XGEN(j)  (2304 + 64 * (j))
#define XB_TOP      3328
#define XB_TOPGEN   3392
#define XCD_BAR_WORDS 3456
#define XB_SPIN_CAP (1u << 18)

__device__ __forceinline__ unsigned xb_ld(unsigned* p)              { return __hip_atomic_load(p, __ATOMIC_RELAXED, __HIP_MEMORY_SCOPE_AGENT); }
__device__ __forceinline__ unsigned xb_add(unsigned* p, unsigned v) { return __hip_atomic_fetch_add(p, v, __ATOMIC_RELAXED, __HIP_MEMORY_SCOPE_AGENT); }
__device__ __forceinline__ unsigned xb_xcc_id() { return (unsigned)__builtin_amdgcn_s_getreg((3 << 11) | 20) & 0xFu; }
#define XB_SPIN(cond, bar) do { unsigned _sp = 0; while (cond) { __builtin_amdgcn_s_sleep(1); \
    if ((++_sp & 255u) == 0u) { if (xb_ld(&(bar)[XB_TMO])) break; if (_sp > XB_SPIN_CAP) { atomicAdd(&(bar)[XB_TMO], 1u); break; } } } } while (0)

struct XcdBarrier {
    unsigned* bar; unsigned x;
    volatile LAS unsigned* st;
};

__device__ __forceinline__ XcdBarrier xcd_barrier_post(unsigned* bar, volatile LAS unsigned* st) {
    XcdBarrier b; b.bar = bar; b.x = xb_xcc_id(); b.st = st;
    if (threadIdx.x == 0) (void)xb_add(&bar[XB_XCNT(b.x)], 1u);
    return b;
}
__device__ __forceinline__ void xcd_barrier_complete(unsigned* bar, unsigned x, unsigned& nloc, unsigned& nx) {
    const unsigned G = gridDim.x * gridDim.y * gridDim.z;
    unsigned sum, cnt, mine, sp = 0u;
    for (;;) {
        sum = 0u; cnt = 0u; mine = 0u;
#pragma unroll
        for (unsigned j = 0; j < 16; ++j) { const unsigned c = xb_ld(&bar[XB_XCNT(j)]); sum += c; cnt += (c > 0u) ? 1u : 0u; mine = (j == x) ? c : mine; }
        if (sum == G) break;
        __builtin_amdgcn_s_sleep(1);
        if ((++sp & 255u) == 0u) { if (xb_ld(&bar[XB_TMO])) break; if (sp > XB_SPIN_CAP) { atomicAdd(&bar[XB_TMO], 1u); break; } }
    }
    nloc = mine > 0u ? mine : 1u; nx = cnt > 0u ? cnt : 1u;
}

__device__ __forceinline__ void xcd_barrier(const XcdBarrier& b) {
    asm volatile("s_waitcnt vmcnt(0)" ::: "memory");
    __syncthreads();
    if (threadIdx.x == 0) {
        unsigned* bar = b.bar;
        __builtin_amdgcn_s_waitcnt(0);
        unsigned nloc = b.st[0], nx = b.st[1];
        if (nloc == 0u) { xcd_barrier_complete(bar, b.x, nloc, nx); b.st[0] = nloc; b.st[1] = nx; }
        const unsigned old = xb_add(&bar[XB_XSUB(b.x)], 1u);
        const unsigned gen = old / nloc;
        if (old + 1u == (gen + 1u) * nloc) {
            __builtin_amdgcn_fence(__ATOMIC_RELEASE, "agent");
            asm volatile("s_waitcnt vmcnt(0)" ::: "memory");
            const unsigned og = xb_add(&bar[XB_TOP], 1u);
            const unsigned tg = og / nx;
            if (og + 1u == (tg + 1u) * nx) xb_add(&bar[XB_TOPGEN], 1u);
            else XB_SPIN(xb_ld(&bar[XB_TOPGEN]) == tg, bar);
            __builtin_amdgcn_fence(__ATOMIC_ACQUIRE, "agent");
            xb_add(&bar[XB_XGEN(b.x)], 1u);
            asm volatile("s_waitcnt vmcnt(0)" ::: "memory");
        } else {
            XB_SPIN(xb_ld(&bar[XB_XGEN(b.x)]) == gen, bar);
            __builtin_amdgcn_fence(__ATOMIC_ACQUIRE, "agent");
            asm volatile("s_waitcnt vmcnt(0)" ::: "memory");
        }
    }
    __syncthreads();
}

__device__ __forceinline__ void xcd_barrier_arrive(const XcdBarrier& b) {
    asm volatile("s_waitcnt vmcnt(0)" ::: "memory");
    __syncthreads();
    if (threadIdx.x == 0) {
        unsigned* bar = b.bar;
        __builtin_amdgcn_s_waitcnt(0);
        unsigned nloc = b.st[0], nx = b.st[1];
        if (nloc == 0u) { xcd_barrier_complete(bar, b.x, nloc, nx); b.st[0] = nloc; b.st[1] = nx; }
        const unsigned old = xb_add(&bar[XB_XSUB(b.x)], 1u);
        const unsigned gen = old / nloc;
        if (old + 1u == (gen + 1u) * nloc) {
            __builtin_amdgcn_fence(__ATOMIC_RELEASE, "agent");
            asm volatile("s_waitcnt vmcnt(0)" ::: "memory");
            const unsigned og = xb_add(&bar[XB_TOP], 1u);
            const unsigned tg = og / nx;
            if (og + 1u == (tg + 1u) * nx) xb_add(&bar[XB_TOPGEN], 1u);
            else XB_SPIN(xb_ld(&bar[XB_TOPGEN]) == tg, bar);
            __builtin_amdgcn_fence(__ATOMIC_ACQUIRE, "agent");
            xb_add(&bar[XB_XGEN(b.x)], 1u);
            asm volatile("s_waitcnt vmcnt(0)" ::: "memory");
            b.st[3] = 0xffffffffu;
        } else b.st[3] = gen;
    }
}
__device__ __forceinline__ void xcd_barrier_finish(const XcdBarrier& b) {
    if (threadIdx.x == 0) {
        unsigned* bar = b.bar; const unsigned gen = b.st[3];
        if (gen != 0xffffffffu) {
            XB_SPIN(xb_ld(&bar[XB_XGEN(b.x)]) == gen, bar);
            __builtin_amdgcn_fence(__ATOMIC_ACQUIRE, "agent");
            asm volatile("s_waitcnt vmcnt(0)" ::: "memory");
        }
    }
    __syncthreads();
}
namespace pg8 {
#define PG8_LAS __attribute__((address_space(3)))
constexpr int BM = 256, BK = 64, HALF = 128, HTB = HALF * BK * 2  , STAGE_BYTES = 8 * HTB, NXCD = 8, WGM = 8;

__host__ __device__ __forceinline__ int lds_byte(int r, int c) { const int st = (r >> 4) * 2 + (c >> 5), rr = r & 15, cc = c & 31, ob = rr * 64 + cc * 2; return st * 1024 + (ob ^ (((ob >> 9) & 1) << 5)); }
__host__ __device__ __forceinline__ void stage_rc(int b, int& R, int& C) { const int st = b / 1024, sb = b % 1024, swz = sb ^ (((sb >> 9) & 1) << 5); R = (st >> 1) * 16 + swz / 64; C = (st & 1) * 32 + (swz % 64) / 2; }
__host__ __device__ __forceinline__ int perm32(int rho) { const int n = rho >> 4, i = rho & 15; return 8 * (i >> 2) + 4 * n + (i & 3); }

struct Unit { const char* aB; const char* bB; int pm, pn, e, row0, nvalid; };

typedef int i32x8 __attribute__((ext_vector_type(8))); typedef int i32x4v __attribute__((ext_vector_type(4)));
__device__ __forceinline__ bf16x8 lo8(i32x8 a) { return __builtin_bit_cast(bf16x8, (i32x4v)__builtin_shufflevector(a, a, 0, 1, 2, 3)); }
__device__ __forceinline__ bf16x8 hi8(i32x8 a) { return __builtin_bit_cast(bf16x8, (i32x4v)__builtin_shufflevector(a, a, 4, 5, 6, 7)); }
__device__ __forceinline__ unsigned cvt_pk_bf16(float lo, float hi) { unsigned r; asm volatile("v_cvt_pk_bf16_f32 %0, %1, %2" : "=v"(r) : "v"(lo), "v"(hi)); return r; }

__device__ __forceinline__ int xcd_remap(int L, int nwg) { const int q = nwg / NXCD, r = nwg % NXCD, xcd = L % NXCD, off = L / NXCD; return (xcd < r ? xcd * (q + 1) : r * (q + 1) + (xcd - r) * q) + off; }

struct DenseOrder {
    const char* A; const char* Bt; int nM, nN, nwg, G, c, K, lim;
    __device__ void init(const bf16_t* A_, const bf16_t* Bt_, int M_, int N_, int K_, int G_, int c_) { A = (const char*)A_; Bt = (const char*)Bt_; nM = M_ / BM; nN = N_ / BM; nwg = nM * nN; G = G_; c = c_; K = K_; lim = 1 << 30; }
    __device__ __forceinline__ bool next(int i, Unit& u) const {
        const long L = (long)i * G + c; if (L >= nwg || i >= lim) return false;
        const int wgid = xcd_remap((int)L, nwg);
        const int nig = WGM * nN, gid = wgid / nig, fm = gid * WGM, gsz = (nM - fm) < WGM ? (nM - fm) : WGM;
        u.pm = fm + ((wgid % nig) % gsz); u.pn = (wgid % nig) / gsz; u.e = 0; u.row0 = u.pm * BM; u.nvalid = BM;
        u.aB = A + (size_t)u.pm * BM * K * 2; u.bB = Bt + (size_t)u.pn * BM * K * 2; return true;
    }
    __device__ __forceinline__ void a_voff(const Unit&, const int (&R)[2], const int (&C)[2], unsigned (&vo)[2][2]) const {
#pragma unroll
        for (int h = 0; h < 2; ++h)
#pragma unroll
            for (int i = 0; i < 2; ++i) vo[h][i] = (unsigned)((R[i] + HALF * h) * K + C[i]) * 2u;
    }
};

template <class Epi, class Sched, bool ALIGN_EPI, bool FP8 = false>
__device__ __forceinline__ void gemm_phase(PG8_LAS unsigned char* lds, const int K, const Sched& S, const Epi& E) {
    const int tid = threadIdx.x, wid = __builtin_amdgcn_readfirstlane(tid >> 6), lane = tid & 63, wr = wid >> 2, wc = wid & 3, fr = lane & 15, fq = lane >> 4;
    constexpr int EB = FP8 ? 1 : 2;
    const int nt = K * EB / 128;
    int RA[2], CA[2]; unsigned voffB[2][2];
#pragma unroll
    for (int i = 0; i < 2; ++i) { int R, C; stage_rc(tid * 16 + i * 8192, R, C); RA[i] = R; CA[i] = C;
#pragma unroll
        for (int h = 0; h < 2; ++h) { int Rb;
            if (Epi::PERM == 2) Rb = 64 * (R >> 5) + 16 * ((R >> 2) & 3) + 8 * h + 4 * ((R >> 4) & 1) + (R & 3);
            else Rb = HALF * h + (Epi::PERM == 1 ? ((R & ~31) + perm32(R & 31)) : R);
            voffB[h][i] = (unsigned)(Rb * K * EB + C * 2); asm volatile("" : "+v"(voffB[h][i])); } }
    const size_t kstep = (size_t)(BK * 2);
    const unsigned ldsw = (unsigned)wid * 1024u;
    const int aoff = lds_byte(wr * 64 + fr, fq * 8), boff = lds_byte(wc * 32 + fr, fq * 8);
#define PG8_SA(b, h) (((b) * 2 + (h)) * HTB)
#define PG8_SB(b, h) ((4 + (b) * 2 + (h)) * HTB)
#define PG8_STAGE(bufoff, gbase, voff) do { _Pragma("unroll") for (int _i = 0; _i < 2; ++_i) \
        __builtin_amdgcn_global_load_lds((const unsigned*)((const char*)(gbase) + (voff)[_i]), (PG8_LAS unsigned*)(lds + (bufoff) + ldsw + _i * 8192), 16, 0, 0); } while (0)
#define PG8_LD8(addr) __builtin_shufflevector(*(const PG8_LAS i32x4v*)(addr), *(const PG8_LAS i32x4v*)((addr) + 1024), 0, 1, 2, 3, 4, 5, 6, 7)
#define PG8_LDA(dst, b, h) do { _Pragma("unroll") for (int m = 0; m < 4; ++m) dst[m] = PG8_LD8(lds + PG8_SA(b, h) + aoff + m * 2048); } while (0)
#define PG8_LDB(dst, b, h) do { _Pragma("unroll") for (int n = 0; n < 2; ++n) dst[n] = PG8_LD8(lds + PG8_SB(b, h) + boff + n * 2048); } while (0)
#define PG8_MMA(ai, bj, At, Bt) do { __builtin_amdgcn_s_setprio(1); _Pragma("unroll") for (int m = 0; m < 4; ++m) _Pragma("unroll") for (int n = 0; n < 2; ++n) { \
        if constexpr (FP8) asm volatile("v_mfma_scale_f32_16x16x128_f8f6f4 %0, %1, %2, %0, %3, %3 op_sel_hi:[0,0,0]" : "+v"(acc[ai][bj][m][n]) : "v"(Bt[n]), "v"(At[m]), "v"(sc7f));   \
        else { acc[ai][bj][m][n] = __builtin_amdgcn_mfma_f32_16x16x32_bf16(lo8(Bt[n]), lo8(At[m]), acc[ai][bj][m][n], 0, 0, 0); \
               acc[ai][bj][m][n] = __builtin_amdgcn_mfma_f32_16x16x32_bf16(hi8(Bt[n]), hi8(At[m]), acc[ai][bj][m][n], 0, 0, 0); } } \
        __builtin_amdgcn_s_setprio(0); } while (0)
#define PG8_WAIT_V(n) asm volatile("s_waitcnt vmcnt(" #n ")" ::: "memory")
#define PG8_WAIT_L(n) asm volatile("s_waitcnt lgkmcnt(" #n ")" ::: "memory")
#define PG8_BAR __builtin_amdgcn_s_barrier()
#define PG8_SCHED __builtin_amdgcn_sched_barrier(0)
    const int sc7f = 0x7F7F7F7F;
    Unit cur, nxt; int ui = 0;
    if (!S.next(0, cur)) return;
    unsigned vA[2][2], vN[2][2];
    S.a_voff(cur, RA, CA, vA);
#define PG8_OPQ(v) do { _Pragma("unroll") for (int h_ = 0; h_ < 2; ++h_) _Pragma("unroll") for (int i_ = 0; i_ < 2; ++i_) asm volatile("" : "+v"(v[h_][i_])); } while (0)
    PG8_OPQ(vA);
    f32x4 acc[2][2][4][2];
#pragma unroll
    for (int a = 0; a < 2; ++a)
#pragma unroll
        for (int b = 0; b < 2; ++b)
#pragma unroll
            for (int m = 0; m < 4; ++m)
#pragma unroll
                for (int n = 0; n < 2; ++n) acc[a][b][m][n] = (f32x4){0.f, 0.f, 0.f, 0.f};
    i32x8 At[4], B0[2], B1[2];
    const char* cA = cur.aB; const char* cB = cur.bB;
    PG8_STAGE(PG8_SB(0, 0), cB, voffB[0]); PG8_STAGE(PG8_SB(0, 1), cB, voffB[1]); PG8_STAGE(PG8_SA(0, 0), cA, vA[0]); PG8_STAGE(PG8_SA(0, 1), cA, vA[1]);
    if (wr == 1) PG8_BAR;
    PG8_WAIT_V(2); PG8_BAR;
    PG8_STAGE(PG8_SB(1, 0), cB + kstep, voffB[0]); PG8_STAGE(PG8_SA(1, 0), cA + kstep, vA[0]); PG8_STAGE(PG8_SB(1, 1), cB + kstep, voffB[1]);
    PG8_WAIT_V(6); PG8_BAR;
    for (;;) {
        const bool has_next = S.next(ui + 1, nxt);
        const char* nA = has_next ? nxt.aB : cA; const char* nB = has_next ? nxt.bB : cB;
        if (has_next) { S.a_voff(nxt, RA, CA, vN); PG8_OPQ(vN); }
        else {
#pragma unroll
            for (int h = 0; h < 2; ++h)
#pragma unroll
                for (int i = 0; i < 2; ++i) vN[h][i] = vA[h][i]; }
#pragma unroll 1
        for (int t = 0; t < nt; t += 2) {
            const bool last = (t == nt - 2);
            const char* a1 = cA + (size_t)(t + 1) * kstep;
            const char* a2 = last ? nA : cA + (size_t)(t + 2) * kstep; const char* b2 = last ? nB : cB + (size_t)(t + 2) * kstep;
            const char* a3 = a2 + kstep; const char* b3 = b2 + kstep;
            unsigned w2[2][2];
#pragma unroll
            for (int h = 0; h < 2; ++h)
#pragma unroll
                for (int i = 0; i < 2; ++i) w2[h][i] = last ? vN[h][i] : vA[h][i];
            PG8_LDB(B0, 0, 0); PG8_LDB(B1, 0, 1); PG8_SCHED; PG8_LDA(At, 0, 0); PG8_STAGE(PG8_SA(1, 1), a1, vA[1]);
            PG8_WAIT_V(8); PG8_WAIT_L(0); PG8_BAR; PG8_MMA(0, 0, At, B0); PG8_MMA(0, 1, At, B1); PG8_BAR; PG8_SCHED;
            PG8_LDA(At, 0, 1); PG8_STAGE(PG8_SB(0, 0), b2, voffB[0]); PG8_STAGE(PG8_SB(0, 1), b2, voffB[1]); PG8_STAGE(PG8_SA(0, 0), a2, w2[0]);
            PG8_WAIT_V(8); PG8_WAIT_L(0); PG8_BAR; PG8_MMA(1, 0, At, B0); PG8_MMA(1, 1, At, B1); PG8_BAR; PG8_SCHED;
            PG8_LDB(B0, 1, 0); PG8_LDB(B1, 1, 1); PG8_SCHED; PG8_LDA(At, 1, 0); PG8_STAGE(PG8_SA(0, 1), a2, w2[1]);
            PG8_WAIT_V(8); PG8_WAIT_L(0); PG8_BAR; PG8_MMA(0, 0, At, B0); PG8_MMA(0, 1, At, B1); PG8_BAR; PG8_SCHED;
            PG8_LDA(At, 1, 1); PG8_STAGE(PG8_SB(1, 0), b3, voffB[0]); PG8_STAGE(PG8_SB(1, 1), b3, voffB[1]); PG8_STAGE(PG8_SA(1, 0), a3, w2[0]);
            PG8_WAIT_V(8); PG8_WAIT_L(0); PG8_BAR; PG8_MMA(1, 0, At, B0); PG8_MMA(1, 1, At, B1); PG8_BAR; PG8_SCHED;
        }
        if constexpr (ALIGN_EPI) { if (wr == 0) PG8_BAR; }
        if constexpr (FP8) {
            asm volatile("s_nop 15\n\ts_nop 15" : "+v"(acc[0][0][0][0]), "+v"(acc[0][0][0][1]), "+v"(acc[0][0][1][0]), "+v"(acc[0][0][1][1]), "+v"(acc[0][0][2][0]), "+v"(acc[0][0][2][1]), "+v"(acc[0][0][3][0]), "+v"(acc[0][0][3][1]),
                                                "+v"(acc[0][1][0][0]), "+v"(acc[0][1][0][1]), "+v"(acc[0][1][1][0]), "+v"(acc[0][1][1][1]), "+v"(acc[0][1][2][0]), "+v"(acc[0][1][2][1]), "+v"(acc[0][1][3][0]), "+v"(acc[0][1][3][1]) :: "memory");
            asm volatile("" : "+v"(acc[1][0][0][0]), "+v"(acc[1][0][0][1]), "+v"(acc[1][0][1][0]), "+v"(acc[1][0][1][1]), "+v"(acc[1][0][2][0]), "+v"(acc[1][0][2][1]), "+v"(acc[1][0][3][0]), "+v"(acc[1][0][3][1]),
                             "+v"(acc[1][1][0][0]), "+v"(acc[1][1][0][1]), "+v"(acc[1][1][1][0]), "+v"(acc[1][1][1][1]), "+v"(acc[1][1][2][0]), "+v"(acc[1][1][2][1]), "+v"(acc[1][1][3][0]), "+v"(acc[1][1][3][1]) :: "memory"); }
        E(acc, cur, wr, wc, fr, fq);
        if (!has_next) break;
#pragma unroll
        for (int a = 0; a < 2; ++a)
#pragma unroll
            for (int b = 0; b < 2; ++b)
#pragma unroll
                for (int m = 0; m < 4; ++m)
#pragma unroll
                    for (int n = 0; n < 2; ++n) acc[a][b][m][n] = (f32x4){0.f, 0.f, 0.f, 0.f};
        cur = nxt; cA = nA; cB = nB; ++ui;
#pragma unroll
        for (int h = 0; h < 2; ++h)
#pragma unroll
            for (int i = 0; i < 2; ++i) vA[h][i] = vN[h][i];
        if constexpr (ALIGN_EPI) { if (wr == 1) PG8_BAR; }
    }
    PG8_WAIT_V(0);
    if constexpr (!ALIGN_EPI) { if (wr == 0) PG8_BAR; }
    PG8_BAR;
#undef PG8_OPQ
#undef PG8_SA
#undef PG8_SB
#undef PG8_STAGE
#undef PG8_LDA
#undef PG8_LDB
#undef PG8_MMA
#undef PG8_WAIT_V
#undef PG8_WAIT_L
#undef PG8_BAR
#undef PG8_SCHED
}

struct EpiBf16 {
    static constexpr int PERM = 1, NST = 16;
    bf16_t* O; int ldc;
    __device__ __forceinline__ void operator()(const f32x4 (&acc)[2][2][4][2], const Unit& u, int wr, int wc, int fr, int fq) const {
        const int row0 = u.row0 + wr * 64 + fr, col0 = u.pn * BM + wc * 32 + 8 * fq;
#pragma unroll
        for (int ai = 0; ai < 2; ++ai)
#pragma unroll
            for (int m = 0; m < 4; ++m) { bf16_t* rowp = O + (size_t)(row0 + ai * HALF + m * 16) * ldc + col0;
#pragma unroll
                for (int bj = 0; bj < 2; ++bj) { const f32x4 v0 = acc[ai][bj][m][0], v1 = acc[ai][bj][m][1];
                    u32x4 w; w.x = cvt_pk_bf16(v0[0], v0[1]); w.y = cvt_pk_bf16(v0[2], v0[3]); w.z = cvt_pk_bf16(v1[0], v1[1]); w.w = cvt_pk_bf16(v1[2], v1[3]);
                    *(u32x4*)(rowp + bj * HALF) = w; } }
    }
};
__device__ __forceinline__ float clamp_fp8(float v) { return __builtin_amdgcn_fmed3f(v, -416.0f, 416.0f); }
__device__ __forceinline__ unsigned pack_fp8x4(const f32x4 v) { int w = 0; w = __builtin_amdgcn_cvt_pk_fp8_f32(clamp_fp8(v[0]), clamp_fp8(v[1]), w, false); w = __builtin_amdgcn_cvt_pk_fp8_f32(clamp_fp8(v[2]), clamp_fp8(v[3]), w, true); return (unsigned)w; }
__device__ __forceinline__ unsigned cvt_fp8x4(const f32x4 v) { int w = 0; w = __builtin_amdgcn_cvt_pk_fp8_f32(v[0], v[1], w, false); w = __builtin_amdgcn_cvt_pk_fp8_f32(v[2], v[3], w, true); return (unsigned)w; }
struct EpiResF32 {
    static constexpr int PERM = 2, NST = 0;
    const float* base; float* out; unsigned char* x8; int ldc;
    __device__ __forceinline__ void operator()(const f32x4 (&acc)[2][2][4][2], const Unit& u, int wr, int wc, int fr, int fq) const {
        const int row0 = u.row0 + wr * 64 + fr, col0 = u.pn * BM + wc * 64 + 16 * fq;
#pragma unroll
        for (int ai = 0; ai < 2; ++ai) { f32x4 rv[4][4];
#pragma unroll
            for (int m = 0; m < 4; ++m) { const size_t off = (size_t)(row0 + ai * HALF + m * 16) * ldc + col0;
#pragma unroll
                for (int c = 0; c < 4; ++c) rv[m][c] = *(const f32x4*)(base + off + 4 * c); }
            asm volatile("" : "+v"(rv[0][0]), "+v"(rv[0][1]), "+v"(rv[0][2]), "+v"(rv[0][3]), "+v"(rv[1][0]), "+v"(rv[1][1]), "+v"(rv[1][2]), "+v"(rv[1][3]),
                              "+v"(rv[2][0]), "+v"(rv[2][1]), "+v"(rv[2][2]), "+v"(rv[2][3]), "+v"(rv[3][0]), "+v"(rv[3][1]), "+v"(rv[3][2]), "+v"(rv[3][3]));
#pragma unroll
            for (int m = 0; m < 4; ++m) { const size_t off = (size_t)(row0 + ai * HALF + m * 16) * ldc + col0; u32x4 w;
#pragma unroll
                for (int bj = 0; bj < 2; ++bj)
#pragma unroll
                    for (int n = 0; n < 2; ++n) { const f32x4 o = rv[m][2 * bj + n] + acc[ai][bj][m][n]; *(f32x4*)(out + off + 8 * bj + 4 * n) = o; w[2 * bj + n] = pack_fp8x4(o); }
                *(u32x4*)(x8 + off) = w; } }
    }
};
__device__ __forceinline__ float silu_mul(float g, float u) { return g * __builtin_amdgcn_rcpf(1.0f + __expf(-g)) * u; }
struct EpiSwiglu {
    static constexpr int PERM = 1, NST = 0;
    unsigned char* H; const float* rl; const float* rstd2; const float* wl;
    __device__ __forceinline__ void operator()(const f32x4 (&acc)[2][2][4][2], const Unit& u, int wr, int wc, int fr, int fq) const {
        const int rt0 = wr * 64 + fr, col0 = u.pn * HALF + wc * 32 + 8 * fq;
        const float* srow = (u.e < NE ? rl + (size_t)u.e * LISTCAP : rstd2) + u.pm * BM;
        const float* wrow = wl + (size_t)(u.e < NE ? u.e : 0) * LISTCAP + u.pm * BM;
        float sv[2][4], wv[2][4];
#pragma unroll
        for (int ai = 0; ai < 2; ++ai)
#pragma unroll
            for (int m = 0; m < 4; ++m) { const int rt = rt0 + ai * HALF + m * 16; sv[ai][m] = srow[rt < u.nvalid ? rt : 0]; wv[ai][m] = wrow[rt < u.nvalid ? rt : 0]; }
        asm volatile("" : "+v"(sv[0][0]), "+v"(sv[0][1]), "+v"(sv[0][2]), "+v"(sv[0][3]), "+v"(sv[1][0]), "+v"(sv[1][1]), "+v"(sv[1][2]), "+v"(sv[1][3]));
        asm volatile("" : "+v"(wv[0][0]), "+v"(wv[0][1]), "+v"(wv[0][2]), "+v"(wv[0][3]), "+v"(wv[1][0]), "+v"(wv[1][1]), "+v"(wv[1][2]), "+v"(wv[1][3]));
#pragma unroll
        for (int ai = 0; ai < 2; ++ai)
#pragma unroll
            for (int m = 0; m < 4; ++m) { const int rt = rt0 + ai * HALF + m * 16;
                if (rt < u.nvalid) { const float s = sv[ai][m] * (1.0f / GU_SCALE), sw = s * ((u.e < NE) ? wv[ai][m] : 1.0f); const f32x4 g0 = acc[ai][0][m][0] * s, g1 = acc[ai][0][m][1] * s, u0 = acc[ai][1][m][0] * sw, u1 = acc[ai][1][m][1] * sw;
                    const f32x4 h0 = {silu_mul(g0[0], u0[0]), silu_mul(g0[1], u0[1]), silu_mul(g0[2], u0[2]), silu_mul(g0[3], u0[3])}, h1 = {silu_mul(g1[0], u1[0]), silu_mul(g1[1], u1[1]), silu_mul(g1[2], u1[2]), silu_mul(g1[3], u1[3])};
                    *(unsigned long long*)(H + (size_t)(u.row0 + rt) * DE + col0) = (unsigned long long)pack_fp8x4(h0) | ((unsigned long long)pack_fp8x4(h1) << 32); } }
    }
};
struct EpiDown8 {
    static constexpr int PERM = 2, NST = 8;
    unsigned char* Y;
    __device__ __forceinline__ void operator()(const f32x4 (&acc)[2][2][4][2], const Unit& u, int wr, int wc, int fr, int fq) const {
        static_assert(YSCALE == DN_SCALE, "accumulators are stored as they are");
        const int rt0 = wr * 64 + fr, col0 = u.pn * BM + wc * 64 + 16 * fq;
#pragma unroll
        for (int ai = 0; ai < 2; ++ai)
#pragma unroll
            for (int m = 0; m < 4; ++m) { const int rt = rt0 + ai * HALF + m * 16;
                u32x4 p; p.x = cvt_fp8x4(acc[ai][0][m][0]); p.y = cvt_fp8x4(acc[ai][0][m][1]); p.z = cvt_fp8x4(acc[ai][1][m][0]); p.w = cvt_fp8x4(acc[ai][1][m][1]);
                const int yrow = (rt < u.nvalid) ? (u.row0 + rt) : (NSLOT + M + rt);
                *(u32x4*)(Y + (size_t)yrow * D + col0) = p; }
    }
};
struct EpiDown {
    static constexpr int PERM = 2, NST = 0;
    unsigned char* Y; const float* wl;
    __device__ __forceinline__ void operator()(const f32x4 (&acc)[2][2][4][2], const Unit& u, int wr, int wc, int fr, int fq) const {
        const int rt0 = wr * 64 + fr, col0 = u.pn * BM + wc * 64 + 16 * fq;
        const float* wrow = wl + (size_t)(u.e < NE ? u.e : 0) * LISTCAP + u.pm * BM;
        float wv[2][4];
#pragma unroll
        for (int ai = 0; ai < 2; ++ai)
#pragma unroll
            for (int m = 0; m < 4; ++m) { const int rt = rt0 + ai * HALF + m * 16; wv[ai][m] = wrow[rt < u.nvalid ? rt : 0]; }
#pragma unroll
        for (int ai = 0; ai < 2; ++ai)
#pragma unroll
            for (int m = 0; m < 4; ++m) { const int rt = rt0 + ai * HALF + m * 16;
                if (rt < u.nvalid) { const float w = ((u.e < NE) ? wv[ai][m] : 1.0f) * (YSCALE / DN_SCALE);
                    u32x4 p; p.x = pack_fp8x4(acc[ai][0][m][0] * w); p.y = pack_fp8x4(acc[ai][0][m][1] * w); p.z = pack_fp8x4(acc[ai][1][m][0] * w); p.w = pack_fp8x4(acc[ai][1][m][1] * w);
                    *(u32x4*)(Y + (size_t)(u.row0 + rt) * D + col0) = p; } }
    }
};

template <bool GATHER> struct GroupedOrder {
    const PG8_LAS int* tpre; const PG8_LAS int* rpre; const PG8_LAS int* ncnt; const PG8_LAS unsigned short* tile_e;
    const char* A; const char* Bt; const int* tok; size_t b_estride; int npn, pn0, nU, G, c, K;
    __device__ __forceinline__ bool next(int i, Unit& u) const {
        const long L = (long)i * G + c; if (L >= nU) return false;
        const int wgid = xcd_remap((int)L, nU), tile = wgid / npn, pnl = wgid % npn;
        const int e = __builtin_amdgcn_readfirstlane((int)tile_e[tile]);
        const int mt = tile - __builtin_amdgcn_readfirstlane(tpre[e]), r0 = __builtin_amdgcn_readfirstlane(rpre[e]) + mt * BM, ne = __builtin_amdgcn_readfirstlane(ncnt[e]);
        u.e = e; u.pm = mt; u.pn = pn0 + pnl; u.row0 = r0; u.nvalid = (ne - mt * BM) < BM ? (ne - mt * BM) : BM;
        u.aB = GATHER ? A : A + (size_t)r0 * K; u.bB = Bt + (size_t)e * b_estride + (size_t)u.pn * BM * K; return true;
    }
    __device__ __forceinline__ void a_voff(const Unit& u, const int (&R)[2], const int (&C)[2], unsigned (&vo)[2][2]) const {
#pragma unroll
        for (int h = 0; h < 2; ++h)
#pragma unroll
            for (int i = 0; i < 2; ++i) { const int rt = R[i] + HALF * h;
                if (GATHER) { int t = 0; if (rt < u.nvalid) t = (u.e < NE) ? tok[(size_t)u.e * LISTCAP + u.pm * BM + rt] : (u.pm * BM + rt);
                    vo[h][i] = (unsigned)(t * K + C[i] * 2); }
                else vo[h][i] = (unsigned)(rt * K + C[i] * 2); }
    }
};

struct Down {
    const PG8_LAS int* tpre; const PG8_LAS int* rpre; const PG8_LAS int* ncnt; const PG8_LAS int* cpre; const PG8_LAS unsigned short* chunk_e;
    const unsigned char* Hb; const unsigned char* Wd; unsigned char* Y; int nU, G, c;
};
template <class Seam>
__device__ __forceinline__ void down_phase(PG8_LAS unsigned char* lds, const Down& P, Seam&& seam) {
    constexpr int K = DE;
    const int tid = threadIdx.x, wid = __builtin_amdgcn_readfirstlane(tid >> 6), lane = tid & 63, wr = wid >> 2, wc = wid & 3, fr = lane & 15, fq = lane >> 4;
    int RA[4], CA[4];
#pragma unroll
    for (int i = 0; i < 4; ++i) { int R, C; stage_rc((tid & 255) * 16 + i * 4096, R, C); RA[i] = R; CA[i] = C; }
    const unsigned ldsw = (unsigned)(wid & 3) * 1024u;
    const int aoff = lds_byte(fr, fq * 8);
    const int sc7f = 0x7F7F7F7F;
#define DN_A(slot, kt, rh) ((slot) * 65536 + ((kt) * 2 + (rh)) * HTB)
#define DN_STAGE_A(slot, abase) do { if (wid < 4) { _Pragma("unroll") for (int kt_ = 0; kt_ < 2; ++kt_) _Pragma("unroll") for (int rh_ = 0; rh_ < 2; ++rh_) _Pragma("unroll") for (int _i = 0; _i < 4; ++_i) \
        __builtin_amdgcn_global_load_lds((const unsigned*)((abase) + (size_t)((rh_ * HALF + RA[_i]) * K + kt_ * 128 + CA[_i] * 2)), (PG8_LAS unsigned*)(lds + DN_A(slot, kt_, rh_) + ldsw + _i * 4096), 16, 0, 0); } } while (0)
#define DN_DECODE(gv, e_, mt_, nt_, cq_) do { const int g_ = (int)(gv); int ef_; \
        if (g_ >= 4 * __builtin_amdgcn_readfirstlane(P.tpre[NE])) ef_ = NE; else ef_ = __popcll(__ballot(4 * P.tpre[lane] <= g_)) - 1;     \
        e_ = __builtin_amdgcn_readfirstlane(ef_); const int tb_ = __builtin_amdgcn_readfirstlane(P.tpre[e_]), tl_ = __builtin_amdgcn_readfirstlane(P.tpre[e_ + 1]) - tb_, lo_ = g_ - 4 * tb_; \
        cq_ = lo_ / tl_; mt_ = lo_ - cq_ * tl_; const int left_ = g1 - g_; nt_ = (tl_ - mt_) < left_ ? (tl_ - mt_) : left_; } while (0)
#define DN_LOADB(BF, e_, cq_) do { const unsigned char* wb_ = P.Wd + ((size_t)(e_) * D + (cq_) * 256 + wc * 64 + 16 * (fr >> 2) + (fr & 3)) * K + 16 * fq; \
        _Pragma("unroll") for (int n_ = 0; n_ < 4; ++n_) _Pragma("unroll") for (int kt_ = 0; kt_ < 2; ++kt_) { const unsigned char* q_ = wb_ + (size_t)(4 * n_) * K + kt_ * 128; \
            BF[n_][kt_] = __builtin_shufflevector(*(const i32x4v*)q_, *(const i32x4v*)(q_ + 64), 0, 1, 2, 3, 4, 5, 6, 7); } } while (0)
    const int wq = (P.G % 8 == 0) ? (P.c % 8) * (P.G / 8) + P.c / 8 : P.c;
    const int g0 = (int)((long)wq * P.nU / P.G), g1 = (int)((long)(wq + 1) * P.nU / P.G);
    long L = g0; if (g0 >= g1) { seam(); return; }
    int e, mt, ntl, cq; DN_DECODE(L, e, mt, ntl, cq);
    i32x8 Bf[4][2], Bn[4][2];
    DN_LOADB(Bf, e, cq);
    seam();
    int r0 = __builtin_amdgcn_readfirstlane(P.rpre[e]) + mt * BM, nrem = __builtin_amdgcn_readfirstlane(P.ncnt[e]) - mt * BM;
    DN_STAGE_A(0, P.Hb + (size_t)r0 * K);
    asm volatile("" : "+v"(Bf[0][0]), "+v"(Bf[0][1]), "+v"(Bf[1][0]), "+v"(Bf[1][1]), "+v"(Bf[2][0]), "+v"(Bf[2][1]), "+v"(Bf[3][0]), "+v"(Bf[3][1]));
    int slot = 0, ti = 0;
    int e2 = e, mt2 = mt, ntl2 = ntl, cq2 = cq;
    asm volatile("s_waitcnt vmcnt(0) lgkmcnt(0)" ::: "memory"); __builtin_amdgcn_s_barrier(); __builtin_amdgcn_sched_barrier(0);
    for (;;) {
        const bool last_tile = (ti + 1 == ntl); const long Ln = L + ntl; const bool has_next_unit = Ln < g1;
        if (ti == 0) { e2 = e; mt2 = mt; ntl2 = ntl; cq2 = cq; if (has_next_unit) { DN_DECODE(Ln, e2, mt2, ntl2, cq2); DN_LOADB(Bn, e2, cq2); } }
        int r0n = r0 + BM, nremn = nrem - BM; bool have = true;
        if (last_tile) { if (has_next_unit) { r0n = __builtin_amdgcn_readfirstlane(P.rpre[e2]) + mt2 * BM; nremn = __builtin_amdgcn_readfirstlane(P.ncnt[e2]) - mt2 * BM; } else have = false; }
        if (have) DN_STAGE_A(slot ^ 1, P.Hb + (size_t)r0n * K);
        const int col0 = cq * 256 + wc * 64 + 16 * fq;
        i32x8 Ag[2][2];
#define DN_LDA(buf, m_) do { _Pragma("unroll") for (int kt = 0; kt < 2; ++kt) { const PG8_LAS unsigned char* a = lds + DN_A(slot, kt, wr) + aoff + (m_) * 2048; \
            Ag[buf][kt] = __builtin_shufflevector(*(const PG8_LAS i32x4v*)a, *(const PG8_LAS i32x4v*)(a + 1024), 0, 1, 2, 3, 4, 5, 6, 7); } } while (0)
        DN_LDA(0, 0);
#pragma unroll
        for (int m = 0; m < 8; ++m) {
            if (m + 1 < 8) DN_LDA((m + 1) & 1, m + 1);
            const i32x8 (&Af)[2] = Ag[m & 1];
            f32x4 acc[4];
#pragma unroll
            for (int n = 0; n < 4; ++n) { acc[n] = __builtin_amdgcn_mfma_scale_f32_16x16x128_f8f6f4(Bf[n][0], Af[0], (f32x4){0.f, 0.f, 0.f, 0.f}, 0, 0, 0, sc7f, 0, sc7f);
                acc[n] = __builtin_amdgcn_mfma_scale_f32_16x16x128_f8f6f4(Bf[n][1], Af[1], acc[n], 0, 0, 0, sc7f, 0, sc7f); }
            const int rt = wr * HALF + m * 16 + fr;
            static_assert(YSCALE == DN_SCALE, "accumulators are stored as they are");
            { u32x4 p; p.x = cvt_fp8x4(acc[0]); p.y = cvt_fp8x4(acc[1]); p.z = cvt_fp8x4(acc[2]); p.w = cvt_fp8x4(acc[3]);
                const int yrow = (rt < nrem) ? (r0 + rt) : (NSLOT + M + rt);
                *(u32x4*)(P.Y + (size_t)yrow * D + col0) = p; }
        }
        if (!have) break;
        if (wid < 4) asm volatile("s_waitcnt vmcnt(8)" ::: "memory");
        asm volatile("s_waitcnt lgkmcnt(0)" ::: "memory");
        __builtin_amdgcn_s_barrier(); __builtin_amdgcn_sched_barrier(0);
        r0 = r0n; nrem = nremn; slot ^= 1;
        if (last_tile) { L = Ln; e = e2; mt = mt2; ntl = ntl2; cq = cq2; ti = 0;
#pragma unroll
            for (int n = 0; n < 4; ++n) { Bf[n][0] = Bn[n][0]; Bf[n][1] = Bn[n][1]; }
            asm volatile("" : "+v"(Bf[0][0]), "+v"(Bf[0][1]), "+v"(Bf[1][0]), "+v"(Bf[1][1]), "+v"(Bf[2][0]), "+v"(Bf[2][1]), "+v"(Bf[3][0]), "+v"(Bf[3][1])); }
        else ++ti;
    }
    __syncthreads();
#undef DN_LDA
#undef DN_A
#undef DN_STAGE_A
#undef DN_DECODE
#undef DN_LOADB
}

__device__ __forceinline__ void down_phase2(PG8_LAS unsigned char* lds, const Down& P) {
    constexpr int K = DE;
    const int tid = threadIdx.x, wid = __builtin_amdgcn_readfirstlane(tid >> 6), lane = tid & 63, wr = wid >> 2, wc = wid & 3, fr = lane & 15, fq = lane >> 4;
    int RA[4], CA[4];
#pragma unroll
    for (int i = 0; i < 4; ++i) { int R, C; stage_rc((tid & 255) * 16 + i * 4096, R, C); RA[i] = R; CA[i] = C; }
    const unsigned ldsw = (unsigned)wc * 1024u;
    const int aoff = lds_byte(fr, fq * 8);
    const int sc7f = 0x7F7F7F7F;
#define DN_A(slot, kt, rh) ((slot) * 65536 + ((kt) * 2 + (rh)) * HTB)
#define DN2_STAGE(slot, r0_) do { const unsigned char* ab_ = P.Hb + (size_t)((r0_) + wr * HALF) * K; _Pragma("unroll") for (int kt_ = 0; kt_ < 2; ++kt_) _Pragma("unroll") for (int _i = 0; _i < 4; ++_i) \
        __builtin_amdgcn_global_load_lds((const unsigned*)(ab_ + (size_t)(RA[_i] * K + kt_ * 128 + CA[_i] * 2)), (PG8_LAS unsigned*)(lds + DN_A(slot, kt_, wr) + ldsw + _i * 4096), 16, 0, 0); } while (0)
#define DN_DECODE(Lv, e_, mt_, nt_, cq_) do { const int wg_ = xcd_remap((int)(Lv), P.nU), chk_ = wg_ >> 2; cq_ = wg_ & 3; e_ = __builtin_amdgcn_readfirstlane((int)P.chunk_e[chk_]); \
        mt_ = (chk_ - __builtin_amdgcn_readfirstlane(P.cpre[e_])) * DCH; const int tl_ = (__builtin_amdgcn_readfirstlane(P.ncnt[e_]) + BM - 1) / BM - mt_; nt_ = tl_ < DCH ? tl_ : DCH; } while (0)
#define DN_LOADB(BF, e_, cq_) do { const unsigned char* wb_ = P.Wd + ((size_t)(e_) * D + (cq_) * 256 + wc * 64 + 16 * (fr >> 2) + (fr & 3)) * K + 16 * fq; \
        _Pragma("unroll") for (int n_ = 0; n_ < 4; ++n_) _Pragma("unroll") for (int kt_ = 0; kt_ < 2; ++kt_) { const unsigned char* q_ = wb_ + (size_t)(4 * n_) * K + kt_ * 128; \
            BF[n_][kt_] = __builtin_shufflevector(*(const i32x4v*)q_, *(const i32x4v*)(q_ + 64), 0, 1, 2, 3, 4, 5, 6, 7); } } while (0)
#define DN2_BAR do { __builtin_amdgcn_s_barrier(); __builtin_amdgcn_sched_barrier(0); } while (0)
    long L = P.c; if (L >= P.nU) return;
    int e, mt, ntl, cq; DN_DECODE(L, e, mt, ntl, cq);
    i32x8 Bf[4][2], Bn[4][2];
    DN_LOADB(Bf, e, cq);
    asm volatile("" : "+v"(Bf[0][0]), "+v"(Bf[0][1]), "+v"(Bf[1][0]), "+v"(Bf[1][1]), "+v"(Bf[2][0]), "+v"(Bf[2][1]), "+v"(Bf[3][0]), "+v"(Bf[3][1]));
    int r0 = __builtin_amdgcn_readfirstlane(P.rpre[e]) + mt * BM, nrem = __builtin_amdgcn_readfirstlane(P.ncnt[e]) - mt * BM;
    long Lf = L; int tif = 0, ntlf = ntl, r0f = r0; bool vf = true;
#define DN2_ADV_F() do { if (tif + 1 < ntlf) { ++tif; r0f += BM; } else { Lf += P.G; if (Lf >= P.nU) vf = false; else { int ef_, mtf_, cqf_; DN_DECODE(Lf, ef_, mtf_, ntlf, cqf_); (void)cqf_; \
            r0f = __builtin_amdgcn_readfirstlane(P.rpre[ef_]) + mtf_ * BM; tif = 0; } } } while (0)
    DN2_STAGE(0, r0f); DN2_ADV_F();
    bool pend = vf;
    if (vf) { DN2_STAGE(1, r0f); DN2_ADV_F(); }
    if (wr == 1) DN2_BAR;
    int slot = 0, ti = 0; bool first = true;
    int e2 = e, mt2 = mt, ntl2 = ntl, cq2 = cq;
    for (;;) {
        if (first) { if (pend) asm volatile("s_waitcnt vmcnt(8)" ::: "memory"); else asm volatile("s_waitcnt vmcnt(0)" ::: "memory"); }
        else { if (pend) asm volatile("s_waitcnt vmcnt(16)" ::: "memory"); else asm volatile("s_waitcnt vmcnt(8)" ::: "memory"); }
        DN2_BAR;
        const bool last_tile = (ti + 1 == ntl); const long Ln = L + P.G; const bool has_next_unit = Ln < P.nU;
        if (ti == 0) { e2 = e; mt2 = mt; ntl2 = ntl; cq2 = cq; if (has_next_unit) { DN_DECODE(Ln, e2, mt2, ntl2, cq2); DN_LOADB(Bn, e2, cq2); } }
        int r0n = r0 + BM, nremn = nrem - BM; bool have = true;
        if (last_tile) { if (has_next_unit) { r0n = __builtin_amdgcn_readfirstlane(P.rpre[e2]) + mt2 * BM; nremn = __builtin_amdgcn_readfirstlane(P.ncnt[e2]) - mt2 * BM; } else have = false; }
        const int col0 = cq * 256 + wc * 64 + 16 * fq;
        i32x8 Ag[2][2];
#define DN_LDA(buf, m_) do { _Pragma("unroll") for (int kt = 0; kt < 2; ++kt) { const PG8_LAS unsigned char* a = lds + DN_A(slot, kt, wr) + aoff + (m_) * 2048; \
            Ag[buf][kt] = __builtin_shufflevector(*(const PG8_LAS i32x4v*)a, *(const PG8_LAS i32x4v*)(a + 1024), 0, 1, 2, 3, 4, 5, 6, 7); } } while (0)
        DN_LDA(0, 0);
#pragma unroll
        for (int m = 0; m < 8; ++m) {
            if (m + 1 < 8) DN_LDA((m + 1) & 1, m + 1);
            const i32x8 (&Af)[2] = Ag[m & 1];
            f32x4 acc[4];
#pragma unroll
            for (int n = 0; n < 4; ++n) { acc[n] = __builtin_amdgcn_mfma_scale_f32_16x16x128_f8f6f4(Bf[n][0], Af[0], (f32x4){0.f, 0.f, 0.f, 0.f}, 0, 0, 0, sc7f, 0, sc7f);
                acc[n] = __builtin_amdgcn_mfma_scale_f32_16x16x128_f8f6f4(Bf[n][1], Af[1], acc[n], 0, 0, 0, sc7f, 0, sc7f); }
            const int rt = wr * HALF + m * 16 + fr;
            static_assert(YSCALE == DN_SCALE, "accumulators are stored as they are");
            { u32x4 p; p.x = cvt_fp8x4(acc[0]); p.y = cvt_fp8x4(acc[1]); p.z = cvt_fp8x4(acc[2]); p.w = cvt_fp8x4(acc[3]);
              const int yrow = (rt < nrem) ? (r0 + rt) : (NSLOT + M + rt);
              *(u32x4*)(P.Y + (size_t)yrow * D + col0) = p; }
        }
        if (last_tile && has_next_unit) {
#pragma unroll
            for (int n = 0; n < 4; ++n) { Bf[n][0] = Bn[n][0]; Bf[n][1] = Bn[n][1]; }
            asm volatile("" : "+v"(Bf[0][0]), "+v"(Bf[0][1]), "+v"(Bf[1][0]), "+v"(Bf[1][1]), "+v"(Bf[2][0]), "+v"(Bf[2][1]), "+v"(Bf[3][0]), "+v"(Bf[3][1])); }
        asm volatile("" ::: "memory");
        DN2_BAR;
        const bool issue = vf;
        if (vf) { DN2_STAGE(slot, r0f); DN2_ADV_F(); }
        asm volatile("" ::: "memory"); __builtin_amdgcn_sched_barrier(0);
        if (!have) break;
        pend = issue; first = false; r0 = r0n; nrem = nremn; slot ^= 1;
        if (last_tile) { L = Ln; e = e2; mt = mt2; ntl = ntl2; cq = cq2; ti = 0; } else ++ti;
    }
    if (wr == 0) DN2_BAR;
    __syncthreads();
#undef DN_LDA
#undef DN_A
#undef DN2_STAGE
#undef DN_DECODE
#undef DN_LOADB
#undef DN2_BAR
#undef DN2_ADV_F
}
}

constexpr int NWAVES = 8;
struct Args { const float* in[19]; float* out; unsigned char* ws; int ph_lo, ph_hi; };

template <bool SCALE>
__device__ __forceinline__ void p0_transpose_item(const float* W, int K, int N, bf16_t* WT, int mode, const float* ksc, LAS float* scr, int item, int lane) {
    const int nblk = N / 64, kb = item / nblk, nb = item % nblk, k0 = 64 * kb, n0 = 64 * nb;
    const int rowbase = (mode == 0) ? n0 : ((n0 >> 7) * 256 + (n0 & 127) + (mode == 2 ? 128 : 0));
    const int r4 = lane >> 4, c16 = lane & 15;
    f32x4 v[16];
#pragma unroll
    for (int i = 0; i < 16; ++i) v[i] = *(const f32x4*)(W + (size_t)(k0 + 4 * i + r4) * N + n0 + 4 * c16);
    const int c = lane & 7, nrow = lane >> 3;
    f32x4 s0 = (f32x4){1.f, 1.f, 1.f, 1.f}, s1 = s0;
    if (SCALE) { s0 = *(const f32x4*)(ksc + k0 + 8 * c); s1 = *(const f32x4*)(ksc + k0 + 8 * c + 4); }
#pragma unroll
    for (int i = 0; i < 16; ++i) { LAS float* d = scr + (4 * i + r4) * 65 + 4 * c16; d[0] = v[i].x; d[1] = v[i].y; d[2] = v[i].z; d[3] = v[i].w; }
    LDS_WAIT(); asm volatile("" ::: "memory");
#pragma unroll
    for (int j = 0; j < 8; ++j) { const int n = nrow + 8 * j; const LAS float* s = scr + (8 * c) * 65 + n;
        v4u o; o.x = pk2(s[0 * 65] * s0.x, s[1 * 65] * s0.y); o.y = pk2(s[2 * 65] * s0.z, s[3 * 65] * s0.w); o.z = pk2(s[4 * 65] * s1.x, s[5 * 65] * s1.y); o.w = pk2(s[6 * 65] * s1.z, s[7 * 65] * s1.w);
        *(GAS v4u*)(WT + (size_t)(rowbase + n) * K + k0 + 8 * c) = o; }
    LDS_WAIT(); asm volatile("" ::: "memory");
}
template <bool SCALE>
__device__ __forceinline__ void p0_transpose_item8(const float* W, int K, int N, unsigned char* WT, int mode, const float* ksc, float scale, LAS float* scr, int item, int lane) {
    const int nblk = N / 32, kb = item / nblk, nb = item % nblk, k0 = 128 * kb, n0 = 32 * nb;
    const int rowbase = (mode == 0) ? n0 : ((n0 >> 7) * 256 + (n0 & 127) + (mode == 2 ? 128 : 0));
    const int r8 = lane >> 3, c8 = lane & 7;
    f32x4 v[16];
#pragma unroll
    for (int i = 0; i < 16; ++i) v[i] = __builtin_nontemporal_load((const f32x4*)(W + (size_t)(k0 + 8 * i + r8) * N + n0 + 4 * c8));
    f32x4 sc4[4];
#pragma unroll
    for (int q = 0; q < 4; ++q) { sc4[q] = (f32x4){scale, scale, scale, scale}; if (SCALE) sc4[q] = *(const f32x4*)(ksc + k0 + 16 * (lane & 7) + 4 * q) * scale; }
#pragma unroll
    for (int i = 0; i < 16; ++i) { LAS float* d = scr + (8 * i + r8) * 33 + ((4 * c8 + 4 * (i >> 1)) & 31); d[0] = v[i].x; d[1] = v[i].y; d[2] = v[i].z; d[3] = v[i].w; }
    LDS_WAIT(); asm volatile("" ::: "memory");
    const int c = lane & 7, nrow = lane >> 3;
#pragma unroll
    for (int j = 0; j < 4; ++j) { const int n = nrow + 8 * j; const LAS float* s = scr + (16 * c) * 33 + ((n + 4 * c) & 31); u32x4 o;
#pragma unroll
        for (int q = 0; q < 4; ++q) { const f32x4 t = {s[(4 * q) * 33] * sc4[q].x, s[(4 * q + 1) * 33] * sc4[q].y, s[(4 * q + 2) * 33] * sc4[q].z, s[(4 * q + 3) * 33] * sc4[q].w}; o[q] = pg8::pack_fp8x4(t); }
        __builtin_nontemporal_store(o, (GAS u32x4*)(WT + (size_t)(rowbase + n) * K + k0 + 16 * c)); }
    LDS_WAIT(); asm volatile("" ::: "memory");
}
template <bool SCALE>
__device__ __forceinline__ void p0_convert_item8(const float* W, int K, int N, unsigned char* WT, int mode, const float* ksc, float scale, int item, int lane) {
    const int nkc = K / 16, nq = item / nkc, k0 = 16 * (item - nq * nkc), n0 = 256 * nq;
    const float* src = W + (size_t)k0 * N + n0 + lane;
    float v[16][4];
#pragma unroll
    for (int j = 0; j < 16; ++j)
#pragma unroll
        for (int nb = 0; nb < 4; ++nb) v[j][nb] = src[(size_t)j * N + 64 * nb];
    f32x4 sc4[4];
#pragma unroll
    for (int q = 0; q < 4; ++q) { sc4[q] = (f32x4){scale, scale, scale, scale}; if (SCALE) sc4[q] = *(const f32x4*)(ksc + k0 + 4 * q) * scale; }
#pragma unroll
    for (int nb = 0; nb < 4; ++nb) { const int n = n0 + 64 * nb + lane; const int row = (mode == 0) ? n : ((n >> 7) * 256 + (n & 127) + (mode == 2 ? 128 : 0)); u32x4 o;
#pragma unroll
        for (int q = 0; q < 4; ++q) { const f32x4 t = {v[4 * q][nb] * sc4[q].x, v[4 * q + 1][nb] * sc4[q].y, v[4 * q + 2][nb] * sc4[q].z, v[4 * q + 3][nb] * sc4[q].w}; o[q] = pg8::pack_fp8x4(t); }
        *(GAS u32x4*)(WT + (size_t)row * K + k0) = o; }
}
struct CvDesc { const float* W; unsigned char* WT; const float* ksc; float scale; int K, N, k0, n0, rowbase; };
__device__ __forceinline__ void cv_load(const CvDesc& d, int lane, f32x4 (&v)[16], f32x4 (&sc4)[4]) {
    const int r8 = lane >> 3, c8 = lane & 7;
#pragma unroll
    for (int i = 0; i < 16; ++i) v[i] = __builtin_nontemporal_load((const f32x4*)(d.W + (size_t)(d.k0 + 8 * i + r8) * d.N + d.n0 + 4 * c8));
    const float* kp = d.ksc ? d.ksc + d.k0 + 16 * c8 : d.W;
    const unsigned km = d.ksc ? 0xffffffffu : 0u, sb = __builtin_bit_cast(unsigned, d.scale);
#pragma unroll
    for (int q = 0; q < 4; ++q) { const f32x4 t = *(const f32x4*)(kp + 4 * q) * d.scale; u32x4 b = __builtin_bit_cast(u32x4, t);
        b.x = (b.x & km) | (sb & ~km); b.y = (b.y & km) | (sb & ~km); b.z = (b.z & km) | (sb & ~km); b.w = (b.w & km) | (sb & ~km); sc4[q] = __builtin_bit_cast(f32x4, b); }
}
__device__ __forceinline__ void cv_store(const CvDesc& d, int lane, const f32x4 (&v)[16], const f32x4 (&sc4)[4], LAS float* scr) {
    const int r8 = lane >> 3, c8 = lane & 7;
#pragma unroll
    for (int i = 0; i < 16; ++i) { LAS float* p = scr + (8 * i + r8) * 33 + ((4 * c8 + 4 * (i >> 1)) & 31); p[0] = v[i].x; p[1] = v[i].y; p[2] = v[i].z; p[3] = v[i].w; }
    LDS_WAIT(); asm volatile("" ::: "memory");
    const int c = lane & 7, nrow = lane >> 3;
#pragma unroll
    for (int j = 0; j < 4; ++j) { const int n = nrow + 8 * j; const LAS float* s = scr + (16 * c) * 33 + ((n + 4 * c) & 31); u32x4 o;
#pragma unroll
        for (int q = 0; q < 4; ++q) { const f32x4 t = {s[(4 * q) * 33] * sc4[q].x, s[(4 * q + 1) * 33] * sc4[q].y, s[(4 * q + 2) * 33] * sc4[q].z, s[(4 * q + 3) * 33] * sc4[q].w}; o[q] = pg8::pack_fp8x4(t); }
        __builtin_nontemporal_store(o, (GAS u32x4*)(d.WT + (size_t)(d.rowbase + n) * d.K + d.k0 + 16 * c)); }
    LDS_WAIT(); asm volatile("" ::: "memory");
}
__device__ __forceinline__ void rms_rows2_to_bf16(const float* xa, const float* xb_, const float* w, bf16_t* oa, bf16_t* ob, int lane) {
    const f32x4* xr0 = (const f32x4*)xa + lane; const f32x4* xr1 = (const f32x4*)xb_ + lane; const f32x4* wr = (const f32x4*)w + lane;
    f32x4 v0[4], v1[4]; float s0 = 0.f, s1 = 0.f;
#pragma unroll
    for (int j = 0; j < 4; ++j) { v0[j] = xr0[64 * j]; v1[j] = xr1[64 * j]; }
#pragma unroll
    for (int j = 0; j < 4; ++j) { s0 += (v0[j].x * v0[j].x + v0[j].y * v0[j].y) + (v0[j].z * v0[j].z + v0[j].w * v0[j].w); s1 += (v1[j].x * v1[j].x + v1[j].y * v1[j].y) + (v1[j].z * v1[j].z + v1[j].w * v1[j].w); }
    const float r0 = 1.0f / sqrtf(wave_sum(s0) * (1.0f / D) + EPS), r1 = 1.0f / sqrtf(wave_sum(s1) * (1.0f / D) + EPS);
    unsigned long long* o0 = (unsigned long long*)oa + lane; unsigned long long* o1 = (unsigned long long*)ob + lane;
#pragma unroll
    for (int j = 0; j < 4; ++j) { const f32x4 ww = wr[64 * j];
        o0[64 * j] = (unsigned long long)pk2(v0[j].x * r0 * ww.x, v0[j].y * r0 * ww.y) | ((unsigned long long)pk2(v0[j].z * r0 * ww.z, v0[j].w * r0 * ww.w) << 32);
        o1[64 * j] = (unsigned long long)pk2(v1[j].x * r1 * ww.x, v1[j].y * r1 * ww.y) | ((unsigned long long)pk2(v1[j].z * r1 * ww.z, v1[j].w * r1 * ww.w) << 32); }
}

__device__ __forceinline__ void rms_rows8_load(const float* x, int m0, int rstride, int lane, f32x4 (&v)[8][4]) {
#pragma unroll
    for (int k = 0; k < 4; ++k)
#pragma unroll
        for (int q = 0; q < 2; ++q) { const f32x4* xr = (const f32x4*)(x + (size_t)(m0 + k * rstride + q) * D) + lane;
#pragma unroll
            for (int j = 0; j < 4; ++j) v[2 * k + q][j] = __builtin_nontemporal_load(xr + 64 * j); }
}
__device__ __forceinline__ void rms_rows8_finish(const f32x4 (&v)[8][4], const float* w, bf16_t* U, int m0, int rstride, int lane) {
    f32x4 ww[4];
#pragma unroll
    for (int j = 0; j < 4; ++j) ww[j] = ((const f32x4*)w)[lane + 64 * j];
    float s[8];
#pragma unroll
    for (int r = 0; r < 8; ++r) { s[r] = 0.f;
#pragma unroll
        for (int j = 0; j < 4; ++j) s[r] += (v[r][j].x * v[r][j].x + v[r][j].y * v[r][j].y) + (v[r][j].z * v[r][j].z + v[r][j].w * v[r][j].w); }
#pragma unroll
    for (int o = 32; o > 0; o >>= 1) {
#pragma unroll
        for (int r = 0; r < 8; ++r) s[r] += __shfl_xor(s[r], o); }
#pragma unroll
    for (int r = 0; r < 8; ++r) { const float rs = 1.0f / sqrtf(s[r] * (1.0f / D) + EPS);
        unsigned long long* o = (unsigned long long*)(U + (size_t)(m0 + (r >> 1) * rstride + (r & 1)) * D) + lane;
#pragma unroll
        for (int j = 0; j < 4; ++j) o[64 * j] = (unsigned long long)pk2(v[r][j].x * rs * ww[j].x, v[r][j].y * rs * ww[j].y) | ((unsigned long long)pk2(v[r][j].z * rs * ww[j].z, v[r][j].w * rs * ww[j].w) << 32); }
}

__device__ __forceinline__ void conv_token(const bf16_t* P, const float* conv_w, const float* nw, bf16_t* ymix, int t, int lane) {
    const int s = t % SEQ, c0 = lane * 8;
    float v[8];
#pragma unroll
    for (int j = 0; j < 8; ++j) v[j] = 0.f;
#pragma unroll
    for (int k = 0; k < 3; ++k) { const int ds = k - 2;
        if (s + ds >= 0) { const bf16_t* row = P + (size_t)(t + ds) * NPROJ; const bf16x8 cg = *(const bf16x8*)(row + OFF_C + c0), hh = *(const bf16x8*)(row + OFF_H + c0);
#pragma unroll
            for (int j = 0; j < 8; ++j) v[j] += conv_w[k * DCONV + c0 + j] * (bf2f((unsigned short)cg[j]) * bf2f((unsigned short)hh[j])); } }
    const bf16x8 bg = *(const bf16x8*)(P + (size_t)t * NPROJ + OFF_B + c0); float ss = 0.f;
#pragma unroll
    for (int j = 0; j < 8; ++j) { v[j] *= bf2f((unsigned short)bg[j]); ss += v[j] * v[j]; }
    const float rstd = 1.0f / sqrtf(wave_sum(ss) * (1.0f / DCONV) + EPS);
    bf16x8 o;
#pragma unroll
    for (int j = 0; j < 8; ++j) o[j] = (short)f2bf(v[j] * rstd * nw[c0 + j]);
    *(bf16x8*)(ymix + (size_t)t * D + c0) = o;
}
constexpr int ATT_VB = 20480;
constexpr int ATT_SSQ = 2 * ATT_VB;
typedef short v4i16_t __attribute__((ext_vector_type(4)));
typedef float f32x2_t __attribute__((ext_vector_type(2))); typedef __bf16 bf16x2_t __attribute__((ext_vector_type(2)));
__device__ __forceinline__ unsigned cvtpk_s(float lo, float hi) { f32x2_t v = {lo, hi}; bf16x2_t b = __builtin_convertvector(v, bf16x2_t); return __builtin_bit_cast(unsigned, b); }
__device__ __forceinline__ v4i16_t vtr(const LAS unsigned char* p) { return __builtin_amdgcn_ds_read_tr16_b64_v4i16((LAS v4i16_t*)p); }
__device__ __forceinline__ void norm_frags(const bf16x8 (&raw)[4], const float* nw, int hf, float extra, bf16x8 (&out)[4]) {
    float ss = 0.f;
#pragma unroll
    for (int s = 0; s < 4; ++s)
#pragma unroll
        for (int j = 0; j < 8; ++j) { const float f = bf2f((unsigned short)raw[s][j]); ss += f * f; }
    ss += __shfl_xor(ss, 32);
    const float rs = extra * __builtin_amdgcn_rsqf(ss * (1.0f / 64) + EPS);
#pragma unroll
    for (int s = 0; s < 4; ++s) { const f32x4 w0 = *(const f32x4*)(nw + 16 * s + 8 * hf), w1 = *(const f32x4*)(nw + 16 * s + 8 * hf + 4);
        u32x4 o;
        o.x = cvtpk_s(bf2f((unsigned short)raw[s][0]) * rs * w0.x, bf2f((unsigned short)raw[s][1]) * rs * w0.y); o.y = cvtpk_s(bf2f((unsigned short)raw[s][2]) * rs * w0.z, bf2f((unsigned short)raw[s][3]) * rs * w0.w);
        o.z = cvtpk_s(bf2f((unsigned short)raw[s][4]) * rs * w1.x, bf2f((unsigned short)raw[s][5]) * rs * w1.y); o.w = cvtpk_s(bf2f((unsigned short)raw[s][6]) * rs * w1.z, bf2f((unsigned short)raw[s][7]) * rs * w1.w);
        out[s] = __builtin_bit_cast(bf16x8, o); }
}
constexpr int ATT_KOFF = 0, ATT_VOFF = 2 * ATT_VB, ATT_SSQ2 = 4 * ATT_VB;
__device__ __forceinline__ void mixer_unit(const bf16_t* P, const float* conv_w, const float* cnw, const float* qnw, const float* knw, const float* sinks, const float* anw, bf16_t* ymix, int t0, LAS unsigned char* lds, int wave, int lane) {
    constexpr float LOG2E = 1.4426950408889634f;
    const int tid = threadIdx.x, s0 = t0 % SEQ, kb0 = t0 - 128;
    const int tw = t0 + 4 * wave, sw = tw % SEQ, c0 = lane * 8;
    bf16x8 cg[6], hh[6], bg[4];
#pragma unroll
    for (int j = 0; j < 6; ++j) { int row = tw - 2 + j; row = row < 0 ? 0 : row; const bf16_t* rp = P + (size_t)row * NPROJ; cg[j] = *(const bf16x8*)(rp + OFF_C + c0); hh[j] = *(const bf16x8*)(rp + OFF_H + c0); }
#pragma unroll
    for (int j = 0; j < 4; ++j) bg[j] = *(const bf16x8*)(P + (size_t)(tw + j) * NPROJ + OFF_B + c0);
    f32x4 cwv[4][2];
#pragma unroll
    for (int q = 0; q < 2; ++q) { cwv[0][q] = *(const f32x4*)(conv_w + c0 + 4 * q); cwv[1][q] = *(const f32x4*)(conv_w + DCONV + c0 + 4 * q); cwv[2][q] = *(const f32x4*)(conv_w + 2 * DCONV + c0 + 4 * q); cwv[3][q] = *(const f32x4*)(cnw + c0 + 4 * q); }
    u32x4 kreg[5], vreg[5];
#pragma unroll
    for (int i = 0; i < 5; ++i) { const int idx = tid + i * 512, piece = idx & 7, key = (idx >> 3) % 160, kvh = idx / 1280; int row = kb0 + key; row = row < 0 ? 0 : row;
        const bf16_t* rp = P + (size_t)row * NPROJ + kvh * 64 + piece * 8; kreg[i] = *(const u32x4*)(rp + OFF_K); vreg[i] = *(const u32x4*)(rp + OFF_V); }
    const int h = wave, kvh = h >> 2, r = lane & 31, hf = lane >> 5;
    bf16x8 qraw[4];
    { const bf16_t* qp = P + (size_t)(t0 + r) * NPROJ + OFF_Q + h * 64 + 8 * hf;
#pragma unroll
      for (int s = 0; s < 4; ++s) qraw[s] = *(const bf16x8*)(qp + 16 * s); }
    { float u[6][8];
#pragma unroll
      for (int j = 0; j < 6; ++j) { const bool ok = (sw - 2 + j) >= 0;
#pragma unroll
          for (int q = 0; q < 8; ++q) u[j][q] = ok ? bf2f((unsigned short)cg[j][q]) * bf2f((unsigned short)hh[j][q]) : 0.f; }
      float w0[8], w1[8], w2[8], nwv[8];
#pragma unroll
      for (int q = 0; q < 8; q += 4) { const f32x4 a = cwv[0][q >> 2], b = cwv[1][q >> 2], c = cwv[2][q >> 2], n = cwv[3][q >> 2];
          w0[q] = a.x; w0[q + 1] = a.y; w0[q + 2] = a.z; w0[q + 3] = a.w; w1[q] = b.x; w1[q + 1] = b.y; w1[q + 2] = b.z; w1[q + 3] = b.w;
          w2[q] = c.x; w2[q + 1] = c.y; w2[q + 2] = c.z; w2[q + 3] = c.w; nwv[q] = n.x; nwv[q + 1] = n.y; nwv[q + 2] = n.z; nwv[q + 3] = n.w; }
      float y[4][8], ss[4];
#pragma unroll
      for (int i = 0; i < 4; ++i) { ss[i] = 0.f;
#pragma unroll
          for (int q = 0; q < 8; ++q) { const float v = w0[q] * u[i][q] + w1[q] * u[i + 1][q] + w2[q] * u[i + 2][q]; y[i][q] = v * bf2f((unsigned short)bg[i][q]); ss[i] += y[i][q] * y[i][q]; } }
#pragma unroll
      for (int o = 1; o < 64; o <<= 1) {
#pragma unroll
          for (int i = 0; i < 4; ++i) ss[i] += __shfl_xor(ss[i], o); }
#pragma unroll
      for (int i = 0; i < 4; ++i) { const float rstd = __builtin_amdgcn_rsqf(ss[i] * (1.0f / DCONV) + EPS); u32x4 o;
          o.x = cvtpk_s(y[i][0] * rstd * nwv[0], y[i][1] * rstd * nwv[1]); o.y = cvtpk_s(y[i][2] * rstd * nwv[2], y[i][3] * rstd * nwv[3]);
          o.z = cvtpk_s(y[i][4] * rstd * nwv[4], y[i][5] * rstd * nwv[5]); o.w = cvtpk_s(y[i][6] * rstd * nwv[6], y[i][7] * rstd * nwv[7]);
          *(u32x4*)(ymix + (size_t)(tw + i) * D + c0) = o; } }
    { const int piece = tid & 7; const f32x4 kw0 = *(const f32x4*)(knw + piece * 8), kw1 = *(const f32x4*)(knw + piece * 8 + 4);
#pragma unroll
      for (int i = 0; i < 5; ++i) { const int idx = tid + i * 512, key = (idx >> 3) % 160, kv = idx / 1280;
          float f[8];
#pragma unroll
          for (int q = 0; q < 4; ++q) { f[2 * q] = __builtin_bit_cast(float, kreg[i][q] << 16); f[2 * q + 1] = __builtin_bit_cast(float, kreg[i][q] & 0xffff0000u); }
          float ss = (f[0] * f[0] + f[1] * f[1]) + (f[2] * f[2] + f[3] * f[3]) + (f[4] * f[4] + f[5] * f[5]) + (f[6] * f[6] + f[7] * f[7]);
          ss += __shfl_xor(ss, 1); ss += __shfl_xor(ss, 2); ss += __shfl_xor(ss, 4);
          const float rs = __builtin_amdgcn_rsqf(ss * (1.0f / 64) + EPS);
          u32x4 o; o.x = cvtpk_s(f[0] * rs * kw0.x, f[1] * rs * kw0.y); o.y = cvtpk_s(f[2] * rs * kw0.z, f[3] * rs * kw0.w); o.z = cvtpk_s(f[4] * rs * kw1.x, f[5] * rs * kw1.y); o.w = cvtpk_s(f[6] * rs * kw1.z, f[7] * rs * kw1.w);
          *(LAS u32x4*)(lds + ATT_KOFF + kv * ATT_VB + key * 128 + ((piece ^ (key & 7)) * 16)) = o;
          *(LAS u32x4*)(lds + ATT_VOFF + kv * ATT_VB + key * 128 + piece * 16) = vreg[i]; } }
    bf16x8 qf[4];
    norm_frags(qraw, qnw, hf, 0.125f * LOG2E, qf);
    __syncthreads();
    const float slope2 = exp2f(-(float)(h + 1)) * LOG2E, sink2 = sinks[h] * LOG2E;
    const int jmin = (128 - s0) > 0 ? (128 - s0) : 0;
    const int dmax = (r + 128 - jmin) < (WIN - 1) ? (r + 128 - jmin) : (WIN - 1);
    float mx = sink2;
    f32x16 p[5];
#pragma unroll
    for (int kb = 0; kb < 5; ++kb) { const int key = 32 * kb + r; const LAS unsigned char* krow = lds + ATT_KOFF + kvh * ATT_VB + key * 128;
#pragma unroll
        for (int i = 0; i < 16; ++i) p[kb][i] = 0.f;
#pragma unroll
        for (int s = 0; s < 4; ++s) { const bf16x8 kf = *(const LAS bf16x8*)(krow + (((2 * s + hf) ^ (key & 7)) * 16)); p[kb] = __builtin_amdgcn_mfma_f32_32x32x16_bf16(kf, qf[s], p[kb], 0, 0, 0); }
        int bk = r + 128 - 32 * kb - 4 * hf; asm volatile("" : "+v"(bk));
        const float sb = slope2 * (float)bk;
        if (kb == 0 || kb == 4 || jmin > 0) {
#pragma unroll
            for (int i = 0; i < 16; ++i) { const int ci = (i & 3) + 8 * (i >> 2); const int dist = bk - ci; const bool valid = (unsigned)dist <= (unsigned)dmax;
                const float v = valid ? p[kb][i] + (slope2 * (float)ci - sb) : -INFINITY; p[kb][i] = v; mx = fmaxf(mx, v); }
        } else {
#pragma unroll
            for (int i = 0; i < 16; ++i) { const int ci = (i & 3) + 8 * (i >> 2); const float v = p[kb][i] + (slope2 * (float)ci - sb); p[kb][i] = v; mx = fmaxf(mx, v); } } }
    mx = fmaxf(mx, __shfl_xor(mx, 32));
    float l = 0.f;
#pragma unroll
    for (int kb = 0; kb < 5; ++kb)
#pragma unroll
        for (int i = 0; i < 16; ++i) { const float e = __builtin_amdgcn_exp2f(p[kb][i] - mx); p[kb][i] = e; l += e; }
    l += __shfl_xor(l, 32); l += __builtin_amdgcn_exp2f(sink2 - mx);
    f32x16 o[2];
#pragma unroll
    for (int i = 0; i < 16; ++i) { o[0][i] = 0.f; o[1][i] = 0.f; }
    { const int i16 = lane & 15, tq = i16 >> 2, tp = i16 & 3, blk = (lane >> 4) & 1;
      const LAS unsigned char* vb = lds + ATT_VOFF + kvh * ATT_VB + (4 * hf + tq) * 128 + (16 * blk + 4 * tp) * 2;
#pragma unroll
      for (int kb = 0; kb < 5; ++kb)
#pragma unroll
          for (int sp = 0; sp < 2; ++sp) { u32x4 pw;
              pw.x = cvtpk_s(p[kb][8 * sp + 0], p[kb][8 * sp + 1]); pw.y = cvtpk_s(p[kb][8 * sp + 2], p[kb][8 * sp + 3]); pw.z = cvtpk_s(p[kb][8 * sp + 4], p[kb][8 * sp + 5]); pw.w = cvtpk_s(p[kb][8 * sp + 6], p[kb][8 * sp + 7]);
              const bf16x8 pf = __builtin_bit_cast(bf16x8, pw);
#pragma unroll
              for (int db = 0; db < 2; ++db) { const LAS unsigned char* a = vb + (32 * kb + 16 * sp) * 128 + db * 64;
                  const v4i16_t lo = vtr(a), hi = vtr(a + 8 * 128);
                  const bf16x8 vf = (bf16x8){lo[0], lo[1], lo[2], lo[3], hi[0], hi[1], hi[2], hi[3]};
                  o[db] = __builtin_amdgcn_mfma_f32_32x32x16_bf16(vf, pf, o[db], 0, 0, 0); } } }
    const float il = __builtin_amdgcn_rcpf(l); float ss = 0.f;
#pragma unroll
    for (int db = 0; db < 2; ++db)
#pragma unroll
        for (int i = 0; i < 16; ++i) { o[db][i] *= il; ss += o[db][i] * o[db][i]; }
    ss += __shfl_xor(ss, 32);
    LAS float* ssq = (LAS float*)(lds + ATT_SSQ2);
    if (hf == 0) ssq[r * 8 + h] = ss;
    f32x4 aw[2][4];
#pragma unroll
    for (int db = 0; db < 2; ++db)
#pragma unroll
        for (int g = 0; g < 4; ++g) aw[db][g] = *(const f32x4*)(anw + h * 64 + db * 32 + 8 * g + 4 * hf);
    __syncthreads();
    float tot = 0.f;
#pragma unroll
    for (int hh2 = 0; hh2 < 8; ++hh2) tot += ssq[r * 8 + hh2];
    const float rstd = __builtin_amdgcn_rsqf(tot * (1.0f / DATT) + EPS);
    bf16_t* op = ymix + (size_t)(t0 + r) * D + DCONV + h * 64 + 4 * hf;
#pragma unroll
    for (int db = 0; db < 2; ++db)
#pragma unroll
        for (int g = 0; g < 4; ++g) { const f32x4 w = aw[db][g];
            const unsigned lo = cvtpk_s(o[db][4 * g] * rstd * w.x, o[db][4 * g + 1] * rstd * w.y), hi = cvtpk_s(o[db][4 * g + 2] * rstd * w.z, o[db][4 * g + 3] * rstd * w.w);
            *(unsigned long long*)(op + db * 32 + 8 * g) = (unsigned long long)lo | ((unsigned long long)hi << 32); }
    __syncthreads();
}

constexpr int RT_CH = 32768;
constexpr int RT_W = 2 * RT_CH;
constexpr int RT_SCR = 4352;
__device__ __forceinline__ unsigned sort_key(float v) { const unsigned u = __builtin_bit_cast(unsigned, v); return u ^ ((unsigned)((int)u >> 31) | 0x80000000u); }
__device__ __forceinline__ void route_block(const float* x1, const bf16_t* Wr  , const float* rbias, float* rstd2, unsigned* cnt, int* tok, float* wl, float* rl, int* inv,
                                            int tb  , LAS unsigned char* lds, int wave, int lane) {
    const int tid = threadIdx.x, row = lane & 15, kg = lane >> 4, wq = wave & 3, g2 = wave >> 2, t0 = tb + 16 * wq + 8 * g2;
    LAS float* lgp = (LAS float*)(lds + RT_W + wave * RT_SCR); LAS float* ssp = lgp + 1024;
    const float* xp = x1 + (size_t)(tb + 16 * wq + row) * D + 512 * g2 + 8 * kg;
    f32x4 acc[4]; float ss = 0.f;
#pragma unroll
    for (int nb = 0; nb < 4; ++nb) acc[nb] = (f32x4){0.f, 0.f, 0.f, 0.f};
    f32x4 xa[8][2][2]; v4u wv[4], wn[4];
#pragma unroll
    for (int c = 0; c < 8; ++c)
#pragma unroll
        for (int s = 0; s < 2; ++s) { xa[c][s][0] = *(const f32x4*)(xp + 64 * c + 32 * s); xa[c][s][1] = *(const f32x4*)(xp + 64 * c + 32 * s + 4); }
#define RT_LOADW(c, WD) do { _Pragma("unroll") for (int i = 0; i < 4; ++i) { const int id = tid + i * 512, gq = id >> 10, r = id & 1023, p = r & 7, e = (r >> 3) & 63, part = r >> 9; \
            WD[i] = *(const v4u*)(Wr + (size_t)part * NE * D + (size_t)e * D + 512 * gq + 64 * (c) + 8 * p); } } while (0)
    RT_LOADW(0, wv);
#pragma unroll
    for (int c = 0; c < 8; ++c) {
        LAS unsigned char* buf = lds + (c & 1) * RT_CH;
#pragma unroll
        for (int i = 0; i < 4; ++i) { const int id = tid + i * 512, gq = id >> 10, r = id & 1023, p = r & 7, e = (r >> 3) & 63, part = r >> 9;
            *(LAS v4u*)(buf + gq * 16384 + part * 8192 + e * 128 + ((p ^ (e & 7)) * 16)) = wv[i]; }
        __syncthreads();
        if (c < 7) RT_LOADW(c + 1, wn);
#pragma unroll
        for (int s = 0; s < 2; ++s) {
            const f32x4 v0 = xa[c][s][0], v1 = xa[c][s][1];
            ss += (v0.x * v0.x + v0.y * v0.y) + (v0.z * v0.z + v0.w * v0.w) + (v1.x * v1.x + v1.y * v1.y) + (v1.z * v1.z + v1.w * v1.w);
            u32x4 hw, lw;
            hw.x = cvtpk_s(v0.x, v0.y); hw.y = cvtpk_s(v0.z, v0.w); hw.z = cvtpk_s(v1.x, v1.y); hw.w = cvtpk_s(v1.z, v1.w);
            lw.x = cvtpk_s(v0.x - __builtin_bit_cast(float, hw.x << 16), v0.y - __builtin_bit_cast(float, hw.x & 0xffff0000u));
            lw.y = cvtpk_s(v0.z - __builtin_bit_cast(float, hw.y << 16), v0.w - __builtin_bit_cast(float, hw.y & 0xffff0000u));
            lw.z = cvtpk_s(v1.x - __builtin_bit_cast(float, hw.z << 16), v1.y - __builtin_bit_cast(float, hw.z & 0xffff0000u));
            lw.w = cvtpk_s(v1.z - __builtin_bit_cast(float, hw.w << 16), v1.w - __builtin_bit_cast(float, hw.w & 0xffff0000u));
            const bf16x8 xh = __builtin_bit_cast(bf16x8, hw), xl = __builtin_bit_cast(bf16x8, lw);
#pragma unroll
            for (int nb = 0; nb < 4; ++nb) { const int e = 16 * nb + row, p = 4 * s + kg; const int off = g2 * 16384 + e * 128 + ((p ^ (e & 7)) * 16);
                const bf16x8 wh = *(const LAS bf16x8*)(buf + off), wlo = *(const LAS bf16x8*)(buf + 8192 + off);
                acc[nb] = __builtin_amdgcn_mfma_f32_16x16x32_bf16(xh, wh, acc[nb], 0, 0, 0);
                acc[nb] = __builtin_amdgcn_mfma_f32_16x16x32_bf16(xl, wh, acc[nb], 0, 0, 0);
                acc[nb] = __builtin_amdgcn_mfma_f32_16x16x32_bf16(xh, wlo, acc[nb], 0, 0, 0); }
        }
        if (c < 7) {
#pragma unroll
            for (int i = 0; i < 4; ++i) wv[i] = wn[i]; }
    }
#undef RT_LOADW
    ss += __shfl_xor(ss, 16); ss += __shfl_xor(ss, 32);
    if (kg == 0) ssp[row] = ss;
#pragma unroll
    for (int nb = 0; nb < 4; ++nb)
#pragma unroll
        for (int i = 0; i < 4; ++i) lgp[(4 * kg + i) * 64 + 16 * nb + row] = acc[nb][i];
    __syncthreads();
    const int tk = lane >> 3, g = lane & 7, tp = 8 * g2 + tk;
    const LAS float* lgA = (const LAS float*)(lds + RT_W + wq * RT_SCR); const LAS float* lgB = (const LAS float*)(lds + RT_W + (wq + 4) * RT_SCR);
    const float rs = 1.0f / sqrtf((lgA[1024 + tp] + lgB[1024 + tp]) * (1.0f / D) + EPS);
    if (g == 0) rstd2[t0 + tk] = rs;
    float sc[8]; unsigned ck[8];
    { const f32x4 l0 = *(const LAS f32x4*)(lgA + tp * 64 + 8 * g) + *(const LAS f32x4*)(lgB + tp * 64 + 8 * g), l1 = *(const LAS f32x4*)(lgA + tp * 64 + 8 * g + 4) + *(const LAS f32x4*)(lgB + tp * 64 + 8 * g + 4);
      const f32x4 b0 = *(const f32x4*)(rbias + 8 * g), b1 = *(const f32x4*)(rbias + 8 * g + 4);
      const float lr[8] = {l0.x, l0.y, l0.z, l0.w, l1.x, l1.y, l1.z, l1.w}, bb[8] = {b0.x, b0.y, b0.z, b0.w, b1.x, b1.y, b1.z, b1.w};
      float m1 = -INFINITY, m2 = -INFINITY;
#pragma unroll
      for (int i = 0; i < 8; ++i) { sc[i] = 1.0f / (1.0f + __expf(-lr[i] * rs)); const float bz = sc[i] + bb[i];
          ck[i] = (sort_key(bz) & ~63u) | (unsigned)(63 - (8 * g + i));
          if (bz > m1) { m2 = m1; m1 = bz; } else if (bz > m2) m2 = bz; }
      const unsigned gk = (sort_key(m1 + m2) & ~7u) | (unsigned)(7 - g); int grank = 0;
#pragma unroll
      for (int d = 1; d < 8; ++d) grank += ((unsigned)__shfl_xor((int)gk, d) > gk) ? 1 : 0;
      if (grank >= TOPG) {
#pragma unroll
          for (int i = 0; i < 8; ++i) ck[i] = 0u; } }
    unsigned selbits = 0u;
#pragma unroll
    for (int r = 0; r < TOPK; ++r) {
        unsigned m = ck[0];
#pragma unroll
        for (int i = 1; i < 8; ++i) m = m > ck[i] ? m : ck[i];
        unsigned o = (unsigned)__shfl_xor((int)m, 1); m = m > o ? m : o; o = (unsigned)__shfl_xor((int)m, 2); m = m > o ? m : o; o = (unsigned)__shfl_xor((int)m, 4); m = m > o ? m : o;
#pragma unroll
        for (int i = 0; i < 8; ++i) { const bool hit = ck[i] == m; selbits |= hit ? (1u << i) : 0u; ck[i] = hit ? 0u : ck[i]; }
    }
    float ssum = 0.f;
#pragma unroll
    for (int i = 0; i < 8; ++i) ssum += ((selbits >> i) & 1u) ? sc[i] : 0.f;
    ssum += __shfl_xor(ssum, 1); ssum += __shfl_xor(ssum, 2); ssum += __shfl_xor(ssum, 4);
    const float wscale = RSCALE / ssum;
    unsigned long long bal[8];
#pragma unroll
    for (int i = 0; i < 8; ++i) bal[i] = __ballot((selbits >> i) & 1u);
    unsigned long long mb = 0ull;
#pragma unroll
    for (int i = 0; i < 8; ++i) mb = ((lane & 7) == i) ? bal[i] : mb;
    const unsigned long long gmask_own = 0x0101010101010101ull << (lane >> 3);
    const int necnt = __popcll(mb & gmask_own);
    LAS int* cw = (LAS int*)(lds + RT_W + 8 * RT_SCR); LAS unsigned* cb = (LAS unsigned*)(cw + 8 * 64);
    cw[wave * 64 + lane] = necnt;
    __syncthreads();
    if (wave == 0) { int tot = 0;
#pragma unroll
        for (int w = 0; w < 8; ++w) tot += cw[w * 64 + lane];
        unsigned b = 0u; if (tot) b = atomicAdd(&cnt[lane * CSTR], (unsigned)tot); cb[lane] = b; }
    __syncthreads();
    unsigned base = cb[lane];
    for (int w = 0; w < wave; ++w) base += (unsigned)cw[w * 64 + lane];
    const int nself = __popc(selbits); int kpre = 0;
#pragma unroll
    for (int d = 1; d < 8; ++d) { const int o = __shfl_xor(nself, d); kpre += ((g ^ d) < g) ? o : 0; }
    const unsigned long long gmask = 0x0101010101010101ull << g, below = (1ull << lane) - 1ull;
#pragma unroll
    for (int i = 0; i < 8; ++i) { const unsigned eb = (unsigned)__shfl((int)base, 8 * g + i);
        if ((selbits >> i) & 1u) { const int e = 8 * g + i; const unsigned pos = eb + (unsigned)__popcll(bal[i] & gmask & below); const size_t li = (size_t)e * LISTCAP + pos;
            tok[li] = t0 + tk; wl[li] = sc[i] * wscale; rl[li] = rs; inv[(size_t)(t0 + tk) * TOPK + kpre + __popc(selbits & ((1u << i) - 1u))] = (e << 16) | (int)pos; } }
    LDS_WAIT(); asm volatile("" ::: "memory");
}

__device__ __forceinline__ void build_group_tables(LAS unsigned char* lds, const unsigned* cnt, int& ntiles) {
    LAS int* tpre = (LAS int*)(lds + TPRE_OFF); LAS int* rpre = (LAS int*)(lds + RPRE_OFF); LAS int* ncnt = (LAS int*)(lds + NCNT_OFF); LAS unsigned short* tile_e = (LAS unsigned short*)(lds + TILEE_OFF);
    LAS int* cpre = (LAS int*)(lds + CPRE_OFF); LAS unsigned short* chunk_e = (LAS unsigned short*)(lds + CHE_OFF);
    if (threadIdx.x < 64) {
        const int lane = threadIdx.x; const int n = (int)cnt[lane * CSTR], tl = (n + 255) >> 8, nc = (tl + DCH - 1) / DCH; int rp = n, tp = tl, cp = nc;
#pragma unroll
        for (int o = 1; o < 64; o <<= 1) { const int a = __shfl_up(rp, o), b = __shfl_up(tp, o), c = __shfl_up(cp, o); if (lane >= o) { rp += a; tp += b; cp += c; } }
        tpre[lane] = tp - tl; rpre[lane] = rp - n; ncnt[lane] = n; cpre[lane] = cp - nc;
        if (lane == 63) { tpre[NE] = tp; rpre[NE] = rp; ncnt[NE] = M; tpre[NEX] = tp + (M >> 8); rpre[NEX] = rp + M; ncnt[NEX] = 0; cpre[NE] = cp; cpre[NEX] = cp + ((M >> 8) + DCH - 1) / DCH; } }
    __syncthreads();
    ntiles = tpre[NEX];
    for (int e = threadIdx.x >> 3; e < NEX; e += 64) { const int a = cpre[e], b = cpre[e + 1]; for (int t = a + (threadIdx.x & 7); t < b; t += 8) chunk_e[t] = (unsigned short)e; }
    for (int e = threadIdx.x >> 3; e < NEX; e += 64) { const int a = tpre[e], b = tpre[e + 1]; for (int t = a + (threadIdx.x & 7); t < b; t += 8) tile_e[t] = (unsigned short)e; }
    __syncthreads();
}

__device__ __forceinline__ void combine_tokens2(const unsigned char* y, const LAS int* rpre, const int* inv, const float* x1, float* outw, int t, int tw, int lane) {
    typedef int i32x4 __attribute__((ext_vector_type(4)));
    i32x4 ip[2][2];
#pragma unroll
    for (int q = 0; q < 2; ++q) { ip[q][0] = *(const i32x4*)(inv + (size_t)(t + q) * TOPK); ip[q][1] = *(const i32x4*)(inv + (size_t)(t + q) * TOPK + 4); }
    u32x4 v[2][9]; f32x4 o[2][4];
#pragma unroll
    for (int q = 0; q < 2; ++q) {
#pragma unroll
        for (int k = 0; k < TOPK; ++k) { const int w = ip[q][k >> 2][k & 3]; const int row = rpre[w >> 16] + (w & 0xffff); v[q][k] = *(const u32x4*)(y + (size_t)row * D + lane * 16); }
        v[q][8] = *(const u32x4*)(y + (size_t)(NSLOT + t + q) * D + lane * 16);
        const float* op = x1 + (size_t)(t + q) * D + lane * 16;
#pragma unroll
        for (int c = 0; c < 4; ++c) o[q][c] = *(const f32x4*)(op + 4 * c); }
#pragma unroll
    for (int q = 0; q < 2; ++q) { float a[16];
#pragma unroll
        for (int j = 0; j < 16; ++j) a[j] = 0.f;
#pragma unroll
        for (int k = 0; k < 9; ++k)
#pragma unroll
            for (int c = 0; c < 4; ++c) { const f32x2_t lo = __builtin_amdgcn_cvt_pk_f32_fp8((int)v[q][k][c], false), hi = __builtin_amdgcn_cvt_pk_f32_fp8((int)v[q][k][c], true);
                a[4 * c] += lo.x; a[4 * c + 1] += lo.y; a[4 * c + 2] += hi.x; a[4 * c + 3] += hi.y; }
        float* ow = outw + (size_t)(tw + q) * D + lane * 16;
#pragma unroll
        for (int c = 0; c < 4; ++c) { f32x4 r = o[q][c]; r.x += a[4 * c] * (1.0f / YSCALE); r.y += a[4 * c + 1] * (1.0f / YSCALE); r.z += a[4 * c + 2] * (1.0f / YSCALE); r.w += a[4 * c + 3] * (1.0f / YSCALE); *(f32x4*)(ow + 4 * c) = r; } }
}

constexpr int I_IN = (D / 64) * (NPROJ / 64), I_OUT = (D / 64) * (D / 64), I_G = (D / 128) * (DE / 32), I_D = (DE / 128) * (D / 32);
constexpr int P0_NITEMS = I_IN + I_OUT + NEX * (2 * I_G + I_D);
#ifndef P0_DEFER
#define P0_DEFER 12480
#endif
#ifndef DOWN_ALIGN
#define DOWN_ALIGN true
#endif
#ifndef CONV_MASK16
#define CONV_MASK16 0xA4A4u
#endif
constexpr int P0_NKEEP = P0_NITEMS - P0_DEFER;
__device__ __forceinline__ void p0_item(const Args& args, unsigned char* ws, int it, LAS float* scr, int lane) {
    unsigned char* Wtd = ws + WS_WTD; bf16_t* Wtin = (bf16_t*)(ws + WS_WTIN); bf16_t* Wtout = (bf16_t*)(ws + WS_WTOUT); unsigned char* Wtgu = ws + WS_WTGU;
    int r = it;
    if (r < I_IN) { p0_transpose_item<false>(args.in[2], D, NPROJ, Wtin, 0, nullptr, scr, r, lane); return; } r -= I_IN;
    if (r < I_OUT) { p0_transpose_item<false>(args.in[9], D, D, Wtout, 0, nullptr, scr, r, lane); return; } r -= I_OUT;
    const int e = r / (2 * I_G + I_D); r -= e * (2 * I_G + I_D);
    const float* sg_ = (e < NE) ? args.in[13] + (size_t)e * D * DE : args.in[16]; const float* su_ = (e < NE) ? args.in[14] + (size_t)e * D * DE : args.in[17]; const float* sd_ = (e < NE) ? args.in[15] + (size_t)e * D * DE : args.in[18];
#ifndef CONV_NOLDS
    if (r < I_G) { p0_transpose_item8<true>(sg_, D, DE, Wtgu + (size_t)e * 512 * D, 1, args.in[10], GU_SCALE, scr, r, lane); return; } r -= I_G;
    if (r < I_G) { p0_transpose_item8<true>(su_, D, DE, Wtgu + (size_t)e * 512 * D, 2, args.in[10], GU_SCALE, scr, r, lane); return; } r -= I_G;
    p0_transpose_item8<false>(sd_, DE, D, Wtd + (size_t)e * D * DE, 0, nullptr, DN_SCALE, scr, r, lane);
#else
    if (r < I_G) { p0_convert_item8<true>(sg_, D, DE, Wtgu + (size_t)e * 512 * D, 1, args.in[10], GU_SCALE, r, lane); return; } r -= I_G;
    if (r < I_G) { p0_convert_item8<true>(su_, D, DE, Wtgu + (size_t)e * 512 * D, 2, args.in[10], GU_SCALE, r, lane); return; } r -= I_G;
    p0_convert_item8<false>(sd_, DE, D, Wtd + (size_t)e * D * DE, 0, nullptr, DN_SCALE, r, lane);
#endif
}

__device__ __forceinline__ CvDesc cv_desc(const Args& args, unsigned char* ws, int it) {
    int r = it - (I_IN + I_OUT); const int e = r / (2 * I_G + I_D); r -= e * (2 * I_G + I_D); const int mat = r / I_G; r -= mat * I_G;
    CvDesc d;
    if (mat < 2) { const float* s = (e < NE) ? args.in[13 + mat] + (size_t)e * D * DE : args.in[16 + mat]; d.W = s; d.K = D; d.N = DE; d.WT = ws + WS_WTGU + (size_t)e * 512 * D; d.ksc = args.in[10]; d.scale = GU_SCALE; }
    else { d.W = (e < NE) ? args.in[15] + (size_t)e * D * DE : args.in[18]; d.K = DE; d.N = D; d.WT = ws + WS_WTD + (size_t)e * D * DE; d.ksc = nullptr; d.scale = DN_SCALE; }
    const int nblk = d.N / 32, kb = r / nblk, nb = r - kb * nblk; d.k0 = 128 * kb; d.n0 = 32 * nb;
    d.rowbase = (mat == 2) ? d.n0 : ((d.n0 >> 7) * 256 + (d.n0 & 127) + (mat == 1 ? 128 : 0));
    return d;
}

#ifndef REP_MASK
#define REP_MASK 0
#endif
#define REPS(k) (1 + ((REP_MASK >> (k)) & 1))
#ifdef TPH
#define TSTAMP(k) do { if (((k) == TPH || (k) == TPH + 1) && blockIdx.x == 0 && tid == 0) { const unsigned long long t_ = __builtin_amdgcn_s_memrealtime(); MISC[16 + 2 * ((k) - TPH)] = (unsigned)t_; MISC[17 + 2 * ((k) - TPH)] = (unsigned)(t_ >> 32); } } while (0)
#else
#define TSTAMP(k) do { } while (0)
#endif
constexpr int N_PHASES = 11;
__global__ void __launch_bounds__(NWAVES * 64, 2) mega_fwd(Args args) {
    extern __shared__ __attribute__((aligned(16))) unsigned char lds_raw[];
    LAS unsigned char* lds = (LAS unsigned char*)lds_raw;
    volatile LAS unsigned* MISC = (volatile LAS unsigned*)(lds + MISC_OFF);
    const int tid = threadIdx.x, lane = tid & 63, wave = __builtin_amdgcn_readfirstlane(tid >> 6);
    const int G = gridDim.x; const int bx = blockIdx.x; const int vcu = (G % 8 == 0) ? (bx % 8) * (G / 8) + bx / 8 : bx;
    unsigned char* ws = args.ws;
    gu32* ctl = (gu32*)(ws + WS_CTL);
    float* out = args.out;
    unsigned* cnt = (unsigned*)(ws + WS_CTL) + CW_CNT;
    int* tok = (int*)(ws + WS_TOK); float* wl = (float*)(ws + WS_WL); int* inv = (int*)(ws + WS_INV);
    bf16_t* Wtd = (bf16_t*)(ws + WS_WTD); bf16_t* P = (bf16_t*)(ws + WS_P); bf16_t* hb = (bf16_t*)(ws + WS_HB); bf16_t* Wtin = (bf16_t*)(ws + WS_WTIN);
    bf16_t* Wtout = (bf16_t*)(ws + WS_WTOUT); bf16_t* Wtgu = (bf16_t*)(ws + WS_WTGU); bf16_t* U = (bf16_t*)(ws + WS_U); bf16_t* ymix = (bf16_t*)(ws + WS_YMIX); bf16_t* Y = (bf16_t*)(ws + WS_Y);

    for (int u = tid; u < 32; u += NWAVES * 64) ((LAS unsigned*)(lds + MISC_OFF))[u] = 0u;
    __syncthreads();
    const int lo = args.ph_lo, hi = args.ph_hi;
    const bool use_bar = (hi - lo) > 1;
    XcdBarrier bar; bar.bar = (unsigned*)(ctl + CW_BAR); bar.x = 0; bar.st = nullptr;
    if (use_bar) bar = xcd_barrier_post((unsigned*)(ctl + CW_BAR), MISC + 8);
#define IN(k) (lo <= (k) && (k) < hi)
#define SEAM(k) do { if (IN(k) && IN((k) + 1)) xcd_barrier(bar); } while (0)
#ifdef SHADOW
    constexpr int SHW = SHADOW, SHN = 256 * SHW, NP1 = P0_DEFER - 4 * SHN;
#define SHADOW_ITEMS(s) do { if (G == 256 && wave >= 1 && wave <= SHW) p0_item(args, ws, P0_NKEEP + NP1 + (s) * SHN + bx * SHW + wave - 1, (LAS float*)(lds + wave * P0SCR), lane); } while (0)
#define SEAM_SH(k, s) do { if (IN(k) && IN((k) + 1)) { xcd_barrier_arrive(bar); SHADOW_ITEMS(s); xcd_barrier_finish(bar); } } while (0)
#else
    constexpr int NP1 = P0_DEFER;
#define SEAM_SH(k, s) SEAM(k)
#endif
    const int gw = vcu * NWAVES + wave, NGW = G * NWAVES;

    TSTAMP(0);
    if (IN(0)) for (int rep_ = 0; rep_ < REPS(0); ++rep_) {
        LAS float* scr = (LAS float*)(lds + wave * P0SCR);
        const bool rows8 = (NGW * 8 == M);
        f32x4 xrow[8][4];
        if (rows8) rms_rows8_load(args.in[0], 2 * gw, 2 * NGW, lane, xrow);
        for (int it = wave * G + vcu; it < P0_NKEEP; it += NGW) p0_item(args, ws, it, scr, lane);
        { bf16_t* Wr = (bf16_t*)(ws + WS_WR); const float* wrt = args.in[11]; const float* fw = args.in[10];
          for (int i = ((NWAVES - 1 - wave) * G + vcu) * 64 + lane; i < NE * (D / 8); i += NGW * 64) {     const int e = i & 63, k8 = (i >> 6) * 8; unsigned hh[4], ll[4];
#pragma unroll
              for (int j = 0; j < 4; ++j) { const float a = wrt[(size_t)(k8 + 2 * j) * NE + e] * fw[k8 + 2 * j], b = wrt[(size_t)(k8 + 2 * j + 1) * NE + e] * fw[k8 + 2 * j + 1];
                  const unsigned ha = f2bf(a), hb2 = f2bf(b); hh[j] = ha | (hb2 << 16); ll[j] = f2bf(a - bf2f((unsigned short)ha)) | (f2bf(b - bf2f((unsigned short)hb2)) << 16); }
              *(v4u*)(Wr + (size_t)e * D + k8) = (v4u){hh[0], hh[1], hh[2], hh[3]}; *(v4u*)(Wr + (size_t)NE * D + (size_t)e * D + k8) = (v4u){ll[0], ll[1], ll[2], ll[3]}; } }
        if (rows8) rms_rows8_finish(xrow, args.in[1], U, 2 * gw, 2 * NGW, lane);
        else for (int m = 2 * gw; m < M; m += 2 * NGW) rms_rows2_to_bf16(args.in[0] + (size_t)m * D, args.in[0] + (size_t)(m + 1) * D, args.in[1], U + (size_t)m * D, U + (size_t)(m + 1) * D, lane);
    }
#ifdef SPLIT_SEAM0
    const bool conv_wg_ = (G == 256) && (P0_DEFER > 0) && ((CONV_MASK16 >> ((bx >> 3) & 15)) & 1u);
#ifdef SHADOW
    if (IN(0) && IN(1)) { xcd_barrier_arrive(bar); SHADOW_ITEMS(0); if (!conv_wg_) xcd_barrier_finish(bar); }
#else
    if (IN(0) && IN(1)) { if (conv_wg_) xcd_barrier_arrive(bar); else xcd_barrier(bar); }
#endif
    TSTAMP(1);
#else
    SEAM(0); TSTAMP(1);
#endif
    if (IN(1)) for (int rep_ = 0; rep_ < REPS(1); ++rep_) {
        const int xs = bx >> 3, xc = bx & 7; const bool split = (G == 256) && (P0_DEFER > 0);
        constexpr unsigned CM = CONV_MASK16; constexpr int NCV = __builtin_popcount(CM) * 16, NGM = 256 - NCV;
        const int below = __builtin_popcount(CM & ((1u << (xs & 15)) - 1u)) + __builtin_popcount(CM) * (xs >> 4);
#ifdef P1_BAL2
        { static_assert(NCV == 96 && P0_NKEEP == I_IN + I_OUT, "P1_BAL2 is laid out for the 96 / 160 split");
            constexpr int NA = P1_NA, NB = P1_NB, NC = P1_NC; static_assert(768 * NA + 512 * NB + 768 * NC >= NP1 && 768 * NA <= NP1, "every item has an owner");
            LAS float* scr = (LAS float*)(lds + wave * P0SCR);
            pg8::DenseOrder S; pg8::EpiBf16 E{P, NPROJ};
            const bool isconv = split && (((CM >> (xs & 15)) & 1u) != 0u); const int q = xc + 8 * below, gi = xc + 8 * (xs - below);
            if (split) {
                if (isconv) { const int cw = q * NWAVES + wave;
                    { f32x4 va[16], vb[16], sa[4], sb[4];
                      CvDesc dc = cv_desc(args, ws, P0_NKEEP + cw); cv_load(dc, lane, va, sa);
#pragma unroll
                      for (int k = 0; k < NA; ++k) { CvDesc dn = dc; if (k + 1 < NA) dn = cv_desc(args, ws, P0_NKEEP + cw + (k + 1) * 768);
                          if (k & 1) { if (k + 1 < NA) cv_load(dn, lane, va, sa); cv_store(dc, lane, vb, sb, scr); }
                          else       { if (k + 1 < NA) cv_load(dn, lane, vb, sb); cv_store(dc, lane, va, sa, scr); }
                          dc = dn; } }
#ifdef SPLIT_SEAM0
                    if (use_bar && lo <= 0) xcd_barrier_finish(bar);
#endif
                    S.init(U, Wtin, M, NPROJ, D, 96, 384 + q); S.lim = 2; __syncthreads(); }
                else { S.init(U, Wtin, M, NPROJ, D, NGM, gi); S.lim = gi < 64 ? 3 : 2; }
            } else S.init(U, Wtin, M, NPROJ, D, G, bx);
            pg8::gemm_phase<pg8::EpiBf16, pg8::DenseOrder, true>(lds, D, S, E);
        }
        { int bxl = (int)blockIdx.x, tdl = (int)threadIdx.x; asm volatile("" : "+s"(bxl)); asm volatile("" : "+v"(tdl));
            const int xs2 = bxl >> 3, xc2 = bxl & 7; constexpr unsigned CM2 = CONV_MASK16;
            const int below2 = __builtin_popcount(CM2 & ((1u << (xs2 & 15)) - 1u)) + __builtin_popcount(CM2) * (xs2 >> 4);
            if ((int)gridDim.x == 256 && !((CM2 >> (xs2 & 15)) & 1u)) { const int gi2 = xc2 + 8 * (xs2 - below2), wave2 = __builtin_amdgcn_readfirstlane(tdl >> 6), lane2 = tdl & 63;
                LAS float* scr2 = (LAS float*)(lds + wave2 * P0SCR);
                const int base = P0_NKEEP + 768 * P1_NA + (gi2 < 64 ? gi2 * NWAVES + wave2 : 512 * P1_NB + (gi2 - 64) * NWAVES + wave2), stride = gi2 < 64 ? 512 : 768, cnt2 = gi2 < 64 ? P1_NB : P1_NC;
                for (int k = 0; k < cnt2; ++k) { const int it = base + k * stride; if (it < P0_NKEEP + NP1) p0_item(args, ws, it, scr2, lane2); } }
        }
#elif defined(P1_BAL)
#ifndef P1_N1
#define P1_N1 13
#endif
        { static_assert(NCV == 96 && P0_NKEEP == I_IN + I_OUT, "P1_BAL is laid out for the 96 / 160 split");
            LAS float* scr = (LAS float*)(lds + wave * P0SCR); constexpr int N1 = P1_N1, CW = 96 * NWAVES, GW = 160 * NWAVES;
            pg8::DenseOrder S; pg8::EpiBf16 E{P, NPROJ};
            const bool isconv = split && (((CM >> (xs & 15)) & 1u) != 0u); const int q = xc + 8 * below, gi = xc + 8 * (xs - below);
            if (split) {
                if (isconv) { const int cw = q * NWAVES + wave;
#ifdef P1_CONVPIPE
                    static_assert(N1 * CW <= NP1, "the unrolled pipeline converts N1 items per wave unconditionally");
                    { f32x4 va[16], vb[16], sa[4], sb[4];
                      CvDesc dc = cv_desc(args, ws, P0_NKEEP + cw); cv_load(dc, lane, va, sa);
#pragma unroll
                      for (int k = 0; k < N1; ++k) { CvDesc dn = dc; if (k + 1 < N1) dn = cv_desc(args, ws, P0_NKEEP + cw + (k + 1) * CW);
                          if (k & 1) { if (k + 1 < N1) cv_load(dn, lane, va, sa); cv_store(dc, lane, vb, sb, scr); }
                          else       { if (k + 1 < N1) cv_load(dn, lane, vb, sb); cv_store(dc, lane, va, sa, scr); }
                          dc = dn; } }
#elif defined(P1_CONVPAIR)
                    for (int k = 0; k < N1; k += 2) { const int it = P0_NKEEP + cw + k * CW; if (it >= P0_NITEMS) break; const bool two = (k + 1 < N1) && (it + CW < P0_NITEMS);
                        f32x4 va[16], vb[16], sa[4], sb[4]; const CvDesc da = cv_desc(args, ws, it), db = cv_desc(args, ws, two ? it + CW : it);
                        cv_load(da, lane, va, sa); if (two) cv_load(db, lane, vb, sb);
                        cv_store(da, lane, va, sa, scr); if (two) cv_store(db, lane, vb, sb, scr); }
#else
                    for (int k = 0; k < N1; ++k) { const int it = P0_NKEEP + cw + k * CW; if (it < P0_NKEEP + NP1) p0_item(args, ws, it, scr, lane); }
#endif
#ifdef SPLIT_SEAM0
                    if (use_bar && lo <= 0) xcd_barrier_finish(bar);
#endif
                    S.init(U, Wtin, M, NPROJ, D, 1, 480 + q); S.lim = 1; __syncthreads(); }
                else { S.init(U, Wtin, M, NPROJ, D, NGM, gi); S.lim = 3; }
            } else S.init(U, Wtin, M, NPROJ, D, G, bx);
            pg8::gemm_phase<pg8::EpiBf16, pg8::DenseOrder, true>(lds, D, S, E);
        }
        {
            int bxl = (int)blockIdx.x, tdl = (int)threadIdx.x; asm volatile("" : "+s"(bxl)); asm volatile("" : "+v"(tdl));
            const int xs2 = bxl >> 3, xc2 = bxl & 7; constexpr unsigned CM2 = CONV_MASK16;
            const int below2 = __builtin_popcount(CM2 & ((1u << (xs2 & 15)) - 1u)) + __builtin_popcount(CM2) * (xs2 >> 4);
            if ((int)gridDim.x == 256 && !((CM2 >> (xs2 & 15)) & 1u)) { const int gi2 = xc2 + 8 * (xs2 - below2), wave2 = __builtin_amdgcn_readfirstlane(tdl >> 6), lane2 = tdl & 63;
                LAS float* scr2 = (LAS float*)(lds + wave2 * P0SCR);
#ifdef P1_TAILPAIR
                for (int it = P0_NKEEP + P1_N1 * 96 * NWAVES + gi2 * NWAVES + wave2; it < P0_NITEMS; it += 2 * 160 * NWAVES) {
                    const bool two = it + 160 * NWAVES < P0_NITEMS;
                    f32x4 va[16], vb[16], sa[4], sb[4]; const CvDesc da = cv_desc(args, ws, it), db = cv_desc(args, ws, two ? it + 160 * NWAVES : it);
                    cv_load(da, lane2, va, sa); if (two) cv_load(db, lane2, vb, sb);
                    cv_store(da, lane2, va, sa, scr2); if (two) cv_store(db, lane2, vb, sb, scr2); }
#else
                for (int it = P0_NKEEP + P1_N1 * 96 * NWAVES + gi2 * NWAVES + wave2; it < P0_NKEEP + NP1; it += 160 * NWAVES) p0_item(args, ws, it, scr2, lane2);
#endif
            }
        }
#else
        if (split && ((CM >> (xs & 15)) & 1u)) {
            LAS float* scr = (LAS float*)(lds + wave * P0SCR); const int q = xc + 8 * below;
#ifndef CONV_PIPE
            for (int it = P0_NKEEP + q * NWAVES + wave; it < P0_NITEMS; it += NCV * NWAVES) p0_item(args, ws, it, scr, lane);
#else
            static_assert(P0_NKEEP >= I_IN + I_OUT, "the conversion workgroups see expert-weight items only");
            constexpr int ST = NCV * NWAVES;
            for (int it = P0_NKEEP + q * NWAVES + wave; it < P0_NITEMS; it += 2 * ST) {
                const bool two = it + ST < P0_NITEMS;
                f32x4 va[16], vb[16], sa[4], sb[4]; const CvDesc da = cv_desc(args, ws, it), db = cv_desc(args, ws, two ? it + ST : it);
                cv_load(da, lane, va, sa); if (two) cv_load(db, lane, vb, sb);
                cv_store(da, lane, va, sa, scr); if (two) cv_store(db, lane, vb, sb, scr);
            }
#endif
        } else {
            pg8::DenseOrder S; if (split) S.init(U, Wtin, M, NPROJ, D, NGM, xc + 8 * (xs - below)); else S.init(U, Wtin, M, NPROJ, D, G, bx);
            pg8::EpiBf16 E{P, NPROJ};
            pg8::gemm_phase<pg8::EpiBf16, pg8::DenseOrder, true>(lds, D, S, E);
        }
#endif
    }
    SEAM_SH(1, 1); TSTAMP(2);
    if (IN(2)) for (int rep_ = 0; rep_ < REPS(2); ++rep_) {
        for (int t0 = vcu * 32; t0 < M; t0 += G * 32) mixer_unit(P, args.in[3], args.in[7], args.in[4], args.in[5], args.in[6], args.in[8], ymix, t0, lds, wave, lane);
    }
    SEAM_SH(2, 2); TSTAMP(3);
#ifdef EXTRA_BAR
    SEAM(2); SEAM(2); SEAM(2); SEAM(2);
#endif
    if (IN(3)) for (int rep_ = 0; rep_ < REPS(3); ++rep_) {
        pg8::DenseOrder S; S.init(ymix, Wtout, M, D, D, G, bx);
        pg8::EpiResF32 E{args.in[0], out, (unsigned char*)U, D};
        pg8::gemm_phase<pg8::EpiResF32, pg8::DenseOrder, false>(lds, D, S, E);
    }
    SEAM_SH(3, 3); TSTAMP(4);
    if (IN(4)) for (int rep_ = 0; rep_ < REPS(4); ++rep_) {
        const bf16_t* Wr = (const bf16_t*)(ws + WS_WR); float* rstd2 = (float*)(ws + WS_RSTD); float* rl = (float*)(ws + WS_RL);
        if (rep_ == 0) { for (int tb = vcu * 64; tb < M; tb += G * 64) route_block(out, Wr, args.in[12], rstd2, cnt, tok, wl, rl, inv, tb, lds, wave, lane); }
        else { unsigned char* dz = ws + WS_HB;
            for (int tb = vcu * 64; tb < M; tb += G * 64) route_block(out, Wr, args.in[12], (float*)(dz + 32 * MiB), cnt + 8192, (int*)dz, (float*)(dz + 8 * MiB), (float*)(dz + 24 * MiB), (int*)(dz + 16 * MiB), tb, lds, wave, lane); }
    }
    SEAM(4); TSTAMP(5);
    int ntiles = 0;
    if (IN(5) || IN(6) || IN(7)) build_group_tables(lds, cnt, ntiles);
    const LAS int* tpre = (const LAS int*)(lds + TPRE_OFF); const LAS int* rpre = (const LAS int*)(lds + RPRE_OFF); const LAS int* ncnt = (const LAS int*)(lds + NCNT_OFF);
    const LAS unsigned short* tile_e = (const LAS unsigned short*)(lds + TILEE_OFF);
    if (IN(5)) for (int rep_ = 0; rep_ < REPS(5); ++rep_) {
        pg8::GroupedOrder<true> S{tpre, rpre, ncnt, tile_e, (const char*)U, (const char*)Wtgu, tok, (size_t)512 * D, 2, 0, ntiles * 2, G, bx, D};
        pg8::EpiSwiglu E{(unsigned char*)hb, (const float*)(ws + WS_RL), (const float*)(ws + WS_RSTD), wl};
        pg8::gemm_phase<pg8::EpiSwiglu, pg8::GroupedOrder<true>, true, true>(lds, D, S, E);
    }
    unsigned char* Y8 = (unsigned char*)Y;
#if defined(DOWN_WS2) || defined(DOWN_GEMM)
    SEAM(5);
#endif
    if (IN(6)) for (int rep_ = 0; rep_ < REPS(6); ++rep_) {
        const LAS int* cpre = (const LAS int*)(lds + CPRE_OFF);
        pg8::Down DP{tpre, rpre, ncnt, cpre, (const LAS unsigned short*)(lds + CHE_OFF), (const unsigned char*)hb, (const unsigned char*)Wtd, Y8, ntiles * 4, G, bx};
#ifdef DOWN_WS2
        pg8::down_phase2(lds, DP);
#elif !defined(DOWN_GEMM)
        pg8::down_phase(lds, DP, [&]() { if (rep_ == 0) { SEAM(5); TSTAMP(6); } });
#else
        pg8::GroupedOrder<false> S{tpre, rpre, ncnt, tile_e, (const char*)hb, (const char*)Wtd, tok, (size_t)D * DE, 4, 0, ntiles * 4, G, bx, DE};
        pg8::EpiDown8 E{Y8};
        pg8::gemm_phase<pg8::EpiDown8, pg8::GroupedOrder<false>, DOWN_ALIGN, true>(lds, DE, S, E);
#endif
    }
    SEAM(6); TSTAMP(7);
    if (IN(7)) for (int rep_ = 0; rep_ < REPS(7); ++rep_) { float* ow = rep_ == 0 ? out : (float*)(ws + WS_END); for (int t = 2 * gw; t < M; t += 2 * NGW) combine_tokens2(Y8, rpre, inv, out, ow, t, rep_ == 0 ? t : (t & 1023), lane); }
    TSTAMP(8);
#ifdef TPH
    if (blockIdx.x == 0 && tid == 0) { const unsigned long long t_a = MISC[16] | ((unsigned long long)MISC[17] << 32), t_b = MISC[18] | ((unsigned long long)MISC[19] << 32); const unsigned long long d = (t_b - t_a) * 10ull, t0 = __builtin_amdgcn_s_memrealtime(); while (__builtin_amdgcn_s_memrealtime() - t0 < d) __builtin_amdgcn_s_sleep(8); }
#endif
#undef IN
#undef SEAM
}

extern "C" void kernel_launch(void* const* d_in, const int* in_sizes, int n_in, void* d_out, int out_size, void* d_ws, size_t ws_size, hipStream_t stream) {
    static int grid = 0;
    if (grid == 0) {
        if (n_in != 19 || in_sizes[0] != M * D || out_size != M * D || ws_size < WS_END) { fprintf(stderr, "kernel_launch: unexpected shapes/ws (n_in %d, ws %zu)\n", n_in, ws_size); grid = -1; return; }
        int dev = 0, cus = 0, per_cu = 0;
        if (hipGetDevice(&dev) != hipSuccess || hipDeviceGetAttribute(&cus, hipDeviceAttributeMultiprocessorCount, dev) != hipSuccess) { grid = -1; return; }
        if (hipFuncSetAttribute((const void*)mega_fwd, hipFuncAttributeMaxDynamicSharedMemorySize, LDS_BYTES) != hipSuccess) { fprintf(stderr, "kernel_launch: hipFuncSetAttribute failed\n"); grid = -1; return; }
        if (hipOccupancyMaxActiveBlocksPerMultiprocessor(&per_cu, (const void*)mega_fwd, NWAVES * 64, LDS_BYTES) != hipSuccess || per_cu < 1) fprintf(stderr, "kernel_launch: occupancy query reports %d\n", per_cu);
        (void)hipGetLastError();
        grid = cus;
    }
    if (grid < 0) return;
    (void)hipMemsetAsync((char*)d_ws + WS_CTL, 0, 64 * 1024, stream);
    Args a{};
    for (int i = 0; i < 19; ++i) a.in[i] = (const float*)d_in[i];
    a.out = (float*)d_out; a.ws = (unsigned char*)d_ws;
#ifndef MK_SPLIT
    a.ph_lo = 0; a.ph_hi = 8;
    hipLaunchKernelGGL(mega_fwd, dim3(grid), dim3(NWAVES * 64), LDS_BYTES, stream, a);
#else
    for (int p = 0; p < 8; ++p) { a.ph_lo = p; a.ph_hi = p + 1; hipLaunchKernelGGL(mega_fwd, dim3(grid), dim3(NWAVES * 64), LDS_BYTES, stream, a); }
#endif
}
```
